# Optimizing an MI355X kernel written in HIP

```python
import math
import jax, jax.numpy as jnp
from jax import lax
import numpy as np

D_MODEL = 1024
BATCH = 16
SEQ = 2048
DEPTH = 2

N_EVEN = (DEPTH + 1) // 2
N_ODD = DEPTH // 2
EPS = 1e-6
NEG = -1e30
TINY = 1e-30
Q_BLOCK = 128

D_FF = 2816

NUM_BUCKETS = 32
MAX_DISTANCE = 2048
N_BIAS_COLS = 16

MLA_HEADS = 8
MLA_Q_RANK = 256
MLA_KV_RANK = 128
MLA_NOPE = 64
MLA_ROPE = 32
MLA_V = 64
MLA_QK_DIM = MLA_NOPE + MLA_ROPE
ROPE_THETA = 10000.0

DIL_PATTERNS = ((128, 1), (512, 4), (2048, 16))
DIL_HEADS_PER_GROUP = 4
DIL_HEADS = DIL_HEADS_PER_GROUP * len(DIL_PATTERNS)
DIL_HEAD_DIM = 64
DIL_BIAS_COL0 = 0

SWA_HEADS = 8
SWA_KV_HEADS = 2
SWA_HEAD_DIM = 64
SWA_WINDOW = 128
SWA_BIAS_COL0 = 0

NSA_HEADS = 8
NSA_KV_HEADS = 2
NSA_HEAD_DIM = 64
NSA_CMP_LEN = 32
NSA_CMP_STRIDE = 16
NSA_CMP_HIDDEN = 128
NSA_SLC_BLOCK = 64
NSA_TOP_N = 16
NSA_WINDOW = 512
NSA_FORCE = 1e6
NSA_BIAS_COL0 = 8

AB_MLA_COLS = MLA_Q_RANK + MLA_KV_RANK + MLA_ROPE
AB_DIL_COLS = 3 * DIL_HEADS * DIL_HEAD_DIM
AB_IN = AB_MLA_COLS + AB_DIL_COLS
AB_MIX = MLA_HEADS * MLA_V + DIL_HEADS_PER_GROUP * DIL_HEAD_DIM
CD_SWA_COLS = (SWA_HEADS + 2 * SWA_KV_HEADS) * SWA_HEAD_DIM
CD_NSA_COLS = NSA_HEADS * NSA_HEAD_DIM + 6 * NSA_KV_HEADS * NSA_HEAD_DIM + 3 * NSA_HEADS
CD_IN = CD_SWA_COLS + CD_NSA_COLS
CD_MIX = SWA_HEADS * SWA_HEAD_DIM + NSA_HEADS * NSA_HEAD_DIM

kernel_name = "hybrid_mla_dilated_swa_nsa_macaron"


def rms_norm(x, g):
    xf = x.astype(jnp.float32)
    y = xf * lax.rsqrt(jnp.mean(xf * xf, axis=-1, keepdims=True) + EPS)
    return (y * g.astype(jnp.float32)).astype(x.dtype)


def qk_norm(x, g):
    xf = x.astype(jnp.float32)
    return xf * lax.rsqrt(jnp.mean(xf * xf, axis=-1, keepdims=True) + EPS) * g.astype(jnp.float32)


def swiglu_half(x, g, w_gate, w_up, w_down):
    h = rms_norm(x, g)
    return (jax.nn.silu(h @ w_gate) * (h @ w_up)) @ w_down


def t5_bucket(dist):
    n = jnp.maximum(dist, 0)
    max_exact = NUM_BUCKETS // 2
    nf = jnp.maximum(n, 1).astype(jnp.float32)
    large = max_exact + (jnp.log(nf / max_exact) / math.log(MAX_DISTANCE / max_exact)
                         * (NUM_BUCKETS - max_exact)).astype(jnp.int32)
    large = jnp.minimum(large, NUM_BUCKETS - 1)
    return jnp.where(n < max_exact, n, large)


def rope(x, pos):
    half = x.shape[-1] // 2
    inv = jnp.power(ROPE_THETA, -jnp.arange(half, dtype=jnp.float32) / half)
    ang = pos[:, None] * inv[None, :]
    cos, sin = jnp.cos(ang)[:, None, :], jnp.sin(ang)[:, None, :]
    x1, x2 = x[..., :half], x[..., half:]
    return jnp.concatenate([x1 * cos - x2 * sin, x2 * cos + x1 * sin], axis=-1)


def causal_block_attention(q, k, v, scale):
    B_, S, H, dk = q.shape
    nb = S // Q_BLOCK
    qb = q.reshape(B_, nb, Q_BLOCK, H, dk).swapaxes(0, 1)
    kpos = jnp.arange(S)

    def one_block(args):
        qi, i = args
        qpos = i * Q_BLOCK + jnp.arange(Q_BLOCK)
        logits = jnp.einsum('bqhd,bkhd->bhqk', qi, k) * scale
        logits = jnp.where(kpos[None, :] <= qpos[:, None], logits, NEG)
        p = jax.nn.softmax(logits, axis=-1)
        return jnp.einsum('bhqk,bkhd->bqhd', p, v)

    out = lax.map(one_block, (qb, jnp.arange(nb)))
    return out.swapaxes(0, 1).reshape(B_, S, H, v.shape[-1])


def banded_attention(q, k, v, window, bias_cols, dist_scale=1, sinks=None):
    B_, S, G, R, dh = q.shape
    nb = -(-S // Q_BLOCK)
    Sp = nb * Q_BLOCK
    n_prev = -(-(window - 1) // Q_BLOCK)
    KW = (n_prev + 1) * Q_BLOCK
    q = jnp.pad(q, ((0, 0), (0, Sp - S), (0, 0), (0, 0), (0, 0)))
    kv_pad = ((0, 0), (n_prev * Q_BLOCK, Sp - S), (0, 0), (0, 0))
    k = jnp.pad(k, kv_pad)
    v = jnp.pad(v, kv_pad)
    qi_ = jnp.arange(Q_BLOCK)
    kc = jnp.arange(KW)
    delta = qi_[:, None] + n_prev * Q_BLOCK - kc[None, :]
    band = (delta >= 0) & (delta < window)
    bias = bias_cols.astype(jnp.float32)[t5_bucket(delta * dist_scale)]
    bias = jnp.transpose(bias.reshape(Q_BLOCK, KW, G, R), (2, 3, 0, 1))
    scale = dh ** -0.5
    qb = q.reshape(B_, nb, Q_BLOCK, G, R, dh).swapaxes(0, 1)

    def one_block(args):
        qblk, i = args
        start = i * Q_BLOCK
        kw = lax.dynamic_slice_in_dim(k, start, KW, axis=1)
        vw = lax.dynamic_slice_in_dim(v, start, KW, axis=1)
        logits = jnp.einsum('bqgrd,bkgd->bgrqk', qblk, kw) * scale + bias
        valid = band & (start - n_prev * Q_BLOCK + kc >= 0)[None, :]
        logits = jnp.where(valid, logits, NEG)
        if sinks is not None:
            sink_col = jnp.broadcast_to(sinks.astype(jnp.float32)[:, :, None, None],
                                        logits.shape[:-1] + (1,))
            logits = jnp.concatenate([logits, sink_col], axis=-1)
        lse = jax.nn.logsumexp(logits, axis=-1, keepdims=True)
        p = jnp.exp(logits - lse)[..., :KW]
        out = jnp.einsum('bgrqk,bkgd->bqgrd', p, vw)
        return out, lse[..., 0]

    out, lse = lax.map(one_block, (qb, jnp.arange(nb)))
    out = out.swapaxes(0, 1).reshape(B_, Sp, G, R, dh)[:, :S]
    lse = jnp.transpose(lse, (1, 0, 4, 2, 3)).reshape(B_, Sp, G, R)[:, :S]
    return out, lse


def mla_mixer(z, q_a_norm, w_q_b, kv_a_norm, w_kv_b, q_gain, k_gain, pos):
    B_, S, _ = z.shape
    c_q, c_kv, k_rope = jnp.split(z, [MLA_Q_RANK, MLA_Q_RANK + MLA_KV_RANK], axis=-1)
    q = (rms_norm(c_q, q_a_norm) @ w_q_b).reshape(B_, S, MLA_HEADS, MLA_QK_DIM)
    kv = (rms_norm(c_kv, kv_a_norm) @ w_kv_b).reshape(B_, S, MLA_HEADS, MLA_NOPE + MLA_V)
    k_nope, v = kv[..., :MLA_NOPE], kv[..., MLA_NOPE:]
    k = jnp.concatenate([k_nope, jnp.broadcast_to(k_rope[:, :, None, :], (B_, S, MLA_HEADS, MLA_ROPE))], axis=-1)
    q = qk_norm(q, q_gain)
    k = qk_norm(k, k_gain)
    q = jnp.concatenate([q[..., :MLA_NOPE], rope(q[..., MLA_NOPE:], pos)], axis=-1)
    k = jnp.concatenate([k[..., :MLA_NOPE], rope(k[..., MLA_NOPE:], pos)], axis=-1)
    return causal_block_attention(q, k, v.astype(jnp.float32), MLA_QK_DIM ** -0.5)


def dilated_mixer(z, q_gain, k_gain, rel_bias):
    B_, S, _ = z.shape
    Hg, dh = DIL_HEADS_PER_GROUP, DIL_HEAD_DIM
    zd = z.reshape(B_, S, 3, len(DIL_PATTERNS), Hg, dh)
    q = qk_norm(zd[:, :, 0], q_gain)
    k = qk_norm(zd[:, :, 1], k_gain)
    v = zd[:, :, 2].astype(jnp.float32)
    outs, lses = [], []
    for g, (w, d) in enumerate(DIL_PATTERNS):
        Sd = S // d

        def to_res(t):
            return t.reshape(B_, Sd, d, Hg, dh).transpose(0, 2, 1, 3, 4).reshape(B_ * d, Sd, Hg, dh)

        cols = rel_bias[:, DIL_BIAS_COL0 + g * Hg: DIL_BIAS_COL0 + (g + 1) * Hg]
        o, lse = banded_attention(to_res(q[:, :, g])[:, :, :, None], to_res(k[:, :, g]), to_res(v[:, :, g]),
                                  w // d + 1, cols, dist_scale=d)
        outs.append(o[:, :, :, 0].reshape(B_, d, Sd, Hg, dh).transpose(0, 2, 1, 3, 4).reshape(B_, S, Hg, dh))
        lses.append(lse[..., 0].reshape(B_, d, Sd, Hg).transpose(0, 2, 1, 3).reshape(B_, S, Hg))
    wts = jax.nn.softmax(jnp.stack(lses), axis=0)
    return jnp.sum(wts[..., None] * jnp.stack(outs), axis=0)


def swa_mixer(z, q_gain, k_gain, sinks, rel_bias):
    B_, S, _ = z.shape
    G, R, dh = SWA_KV_HEADS, SWA_HEADS // SWA_KV_HEADS, SWA_HEAD_DIM
    zq, zk, zv = jnp.split(z, [SWA_HEADS * dh, SWA_HEADS * dh + G * dh], axis=-1)
    q = qk_norm(zq.reshape(B_, S, G, R, dh), q_gain)
    k = qk_norm(zk.reshape(B_, S, G, dh), k_gain)
    v = zv.reshape(B_, S, G, dh).astype(jnp.float32)
    cols = rel_bias[:, SWA_BIAS_COL0:SWA_BIAS_COL0 + SWA_HEADS]
    o, _ = banded_attention(q, k, v, SWA_WINDOW, cols, sinks=sinks.reshape(G, R))
    return o.reshape(B_, S, SWA_HEADS * dh)


def nsa_mixer(z, q_gain, k_gains, cmp_pos, cmp_w1, cmp_w2, rel_bias):
    B_, S, _ = z.shape
    G, R, dh = NSA_KV_HEADS, NSA_HEADS // NSA_KV_HEADS, NSA_HEAD_DIM
    f32 = jnp.float32
    offs = np.cumsum([NSA_HEADS * dh] + [G * dh] * 6).tolist()
    zq, zkc, zvc, zks, zvs, zkw, zvw, zg = jnp.split(z, offs, axis=-1)
    q = qk_norm(zq.reshape(B_, S, G, R, dh), q_gain)

    def kvs(t):
        return t.reshape(B_, S, G, dh)

    scale = dh ** -0.5
    cols = rel_bias[:, NSA_BIAS_COL0:NSA_BIAS_COL0 + NSA_HEADS]
    tq = jnp.arange(S)

    n_cmp = (S - NSA_CMP_LEN) // NSA_CMP_STRIDE + 1
    blk_idx = np.arange(n_cmp)[:, None] * NSA_CMP_STRIDE + np.arange(NSA_CMP_LEN)[None, :]

    def compress(t, pos_emb, w1, w2):
        blocks = kvs(t)[:, blk_idx] + pos_emb[:, None, :]
        flat = blocks.transpose(0, 1, 3, 2, 4).reshape(B_, n_cmp, G, NSA_CMP_LEN * dh)
        return jax.nn.gelu(flat @ w1) @ w2

    k_c = qk_norm(compress(zkc, cmp_pos[0], cmp_w1[0], cmp_w2[0]), k_gains[0])
    v_c = compress(zvc, cmp_pos[1], cmp_w1[1], cmp_w2[1]).astype(f32)
    cmp_ok = jnp.asarray(blk_idx[:, -1])[None, :] <= tq[:, None]
    logits = jnp.einsum('bsgrd,bcgd->bgrsc', q, k_c) * scale
    logits = jnp.where(cmp_ok, logits, NEG)
    e = jnp.exp(logits - jnp.max(logits, axis=-1, keepdims=True)) * cmp_ok
    p_cmp = e / jnp.maximum(jnp.sum(e, axis=-1, keepdims=True), TINY)
    o_cmp = jnp.einsum('bgrsc,bcgd->bsgrd', p_cmp, v_c)

    n_slc = S // NSA_SLC_BLOCK
    ci = np.arange(n_cmp)[:, None] * NSA_CMP_STRIDE
    sj = np.arange(n_slc)[None, :] * NSA_SLC_BLOCK
    overlap = jnp.asarray(((ci < sj + NSA_SLC_BLOCK) & (ci + NSA_CMP_LEN > sj)).astype(np.float32))
    imp = jnp.einsum('bgrsc,cj->bgsj', p_cmp, overlap)
    tb = tq // NSA_SLC_BLOCK
    jj = jnp.arange(n_slc)
    causal_blk = jj[None, :] <= tb[:, None]
    forced = (jj[None, :] == 0) | (jj[None, :] == tb[:, None]) | (jj[None, :] == tb[:, None] - 1)
    score = jnp.where(causal_blk, imp + jnp.where(forced, NSA_FORCE, 0.0), -NSA_FORCE)
    top_n = min(NSA_TOP_N, n_slc)
    _, sel = lax.top_k(score, top_n)

    k_s = qk_norm(kvs(zks), k_gains[1]).transpose(0, 2, 1, 3).reshape(B_, G, n_slc, NSA_SLC_BLOCK, dh)
    v_s = kvs(zvs).astype(f32).transpose(0, 2, 1, 3).reshape(B_, G, n_slc, NSA_SLC_BLOCK, dh)
    nb = S // Q_BLOCK
    q_blk = q.transpose(0, 2, 3, 1, 4).reshape(B_, G, R, nb, Q_BLOCK, dh).transpose(3, 0, 1, 2, 4, 5)
    sel_blk = sel.reshape(B_, G, nb, Q_BLOCK, top_n).transpose(2, 0, 1, 3, 4)
    bias_gr = cols.astype(f32).T.reshape(G, R, NUM_BUCKETS)
    b_ix = jnp.arange(B_)[:, None, None, None]
    g_ix = jnp.arange(G)[None, :, None, None]
    g6 = jnp.arange(G)[None, :, None, None, None, None]
    r6 = jnp.arange(R)[None, None, :, None, None, None]
    tok = jnp.arange(NSA_SLC_BLOCK)

    def slc_block(args):
        qi, si, i = args
        kg = k_s[b_ix, g_ix, si]
        vg = v_s[b_ix, g_ix, si]
        dist = (i * Q_BLOCK + jnp.arange(Q_BLOCK))[None, None, :, None, None] - (si[..., None] * NSA_SLC_BLOCK + tok)
        bias = bias_gr[g6, r6, t5_bucket(dist)[:, :, None]]
        lg = jnp.einsum('bgrqd,bgqnkd->bgrqnk', qi, kg) * scale + bias
        lg = jnp.where((dist >= 0)[:, :, None], lg, NEG)
        p = jax.nn.softmax(lg, axis=(-2, -1))
        return jnp.einsum('bgrqnk,bgqnkd->bqgrd', p, vg)

    o_slc = lax.map(slc_block, (q_blk, sel_blk, jnp.arange(nb))).swapaxes(0, 1).reshape(B_, S, G, R, dh)

    o_win, _ = banded_attention(q, qk_norm(kvs(zkw), k_gains[2]), kvs(zvw).astype(f32), NSA_WINDOW, cols)

    gate = jax.nn.sigmoid(zg.astype(f32)).reshape(B_, S, G, R, 3)
    out = gate[..., 0:1] * o_cmp + gate[..., 1:2] * o_slc + gate[..., 2:3] * o_win
    return out.reshape(B_, S, NSA_HEADS * dh)


def setup_inputs(seed: int = 0) -> dict:
    key = jax.random.key(seed)
    keys = iter(jax.random.split(key, 48))
    f32 = jnp.float32

    def w(shape, fan_in):
        return jax.random.normal(next(keys), shape, f32) * fan_in ** -0.5

    def gain(shape):
        return 1.0 + 0.05 * jax.random.normal(next(keys), shape, f32)

    NE, NO = N_EVEN, N_ODD
    return {
        "x": jax.random.normal(next(keys), (BATCH, SEQ, D_MODEL), f32),
        "rel_bias": 0.5 * jax.random.normal(next(keys), (NUM_BUCKETS, N_BIAS_COLS), f32),
        "ffn1_norm": gain((DEPTH, D_MODEL)),
        "ffn1_w_gate": w((DEPTH, D_MODEL, D_FF), D_MODEL),
        "ffn1_w_up": w((DEPTH, D_MODEL, D_FF), D_MODEL),
        "ffn1_w_down": w((DEPTH, D_FF, D_MODEL), D_FF),
        "mix_norm": gain((DEPTH, D_MODEL)),
        "ffn2_norm": gain((DEPTH, D_MODEL)),
        "ffn2_w_gate": w((DEPTH, D_MODEL, D_FF), D_MODEL),
        "ffn2_w_up": w((DEPTH, D_MODEL, D_FF), D_MODEL),
        "ffn2_w_down": w((DEPTH, D_FF, D_MODEL), D_FF),
        "ab_w_in": w((NE, D_MODEL, AB_IN), D_MODEL),
        "mla_q_a_norm": gain((NE, MLA_Q_RANK)),
        "mla_w_q_b": w((NE, MLA_Q_RANK, MLA_HEADS * MLA_QK_DIM), MLA_Q_RANK),
        "mla_kv_a_norm": gain((NE, MLA_KV_RANK)),
        "mla_w_kv_b": w((NE, MLA_KV_RANK, MLA_HEADS * (MLA_NOPE + MLA_V)), MLA_KV_RANK),
        "mla_q_norm": gain((NE, MLA_QK_DIM)),
        "mla_k_norm": gain((NE, MLA_QK_DIM)),
        "dil_q_norm": gain((NE, DIL_HEAD_DIM)),
        "dil_k_norm": gain((NE, DIL_HEAD_DIM)),
        "ab_w_out": w((NE, AB_MIX, D_MODEL), AB_MIX),
        "cd_w_in": w((NO, D_MODEL, CD_IN), D_MODEL),
        "swa_q_norm": gain((NO, SWA_HEAD_DIM)),
        "swa_k_norm": gain((NO, SWA_HEAD_DIM)),
        "swa_sinks": jax.random.normal(next(keys), (NO, SWA_HEADS), f32),
        "nsa_q_norm": gain((NO, NSA_HEAD_DIM)),
        "nsa_k_norm": gain((NO, 3, NSA_HEAD_DIM)),
        "nsa_cmp_pos": 0.1 * jax.random.normal(next(keys), (NO, 2, NSA_CMP_LEN, NSA_HEAD_DIM), f32),
        "nsa_cmp_w1": w((NO, 2, NSA_CMP_LEN * NSA_HEAD_DIM, NSA_CMP_HIDDEN), NSA_CMP_LEN * NSA_HEAD_DIM),
        "nsa_cmp_w2": w((NO, 2, NSA_CMP_HIDDEN, NSA_HEAD_DIM), NSA_CMP_HIDDEN),
        "cd_w_out": w((NO, CD_MIX, D_MODEL), CD_MIX),
    }


def reference(x, rel_bias, ffn1_norm, ffn1_w_gate, ffn1_w_up, ffn1_w_down, mix_norm,
              ffn2_norm, ffn2_w_gate, ffn2_w_up, ffn2_w_down, ab_w_in, mla_q_a_norm, mla_w_q_b,
              mla_kv_a_norm, mla_w_kv_b, mla_q_norm, mla_k_norm, dil_q_norm, dil_k_norm, ab_w_out,
              cd_w_in, swa_q_norm, swa_k_norm, swa_sinks, nsa_q_norm, nsa_k_norm, nsa_cmp_pos,
              nsa_cmp_w1, nsa_cmp_w2, cd_w_out):
    B_, S, _ = x.shape
    pos = jnp.arange(S, dtype=jnp.float32)
    for layer in range(DEPTH):
        x = x + 0.5 * swiglu_half(x, ffn1_norm[layer], ffn1_w_gate[layer], ffn1_w_up[layer], ffn1_w_down[layer])
        h = rms_norm(x, mix_norm[layer])
        if layer % 2 == 0:
            e = layer // 2
            z = h @ ab_w_in[e]
            o_a = mla_mixer(z[..., :AB_MLA_COLS], mla_q_a_norm[e], mla_w_q_b[e], mla_kv_a_norm[e],
                            mla_w_kv_b[e], mla_q_norm[e], mla_k_norm[e], pos)
            o_b = dilated_mixer(z[..., AB_MLA_COLS:], dil_q_norm[e], dil_k_norm[e], rel_bias)
            mixed = jnp.concatenate([o_a.reshape(B_, S, -1), o_b.reshape(B_, S, -1)], axis=-1)
            mixed = mixed.astype(x.dtype) @ ab_w_out[e]
        else:
            o = layer // 2
            z = h @ cd_w_in[o]
            o_c = swa_mixer(z[..., :CD_SWA_COLS], swa_q_norm[o], swa_k_norm[o], swa_sinks[o], rel_bias)
            o_d = nsa_mixer(z[..., CD_SWA_COLS:], nsa_q_norm[o], nsa_k_norm[o], nsa_cmp_pos[o],
                            nsa_cmp_w1[o], nsa_cmp_w2[o], rel_bias)
            mixed = jnp.concatenate([o_c, o_d], axis=-1).astype(x.dtype) @ cd_w_out[o]
        x = x + mixed
        x = x + 0.5 * swiglu_half(x, ffn2_norm[layer], ffn2_w_gate[layer], ffn2_w_up[layer], ffn2_w_down[layer])
    return x
```

```cpp
#include <hip/hip_runtime.h>
#include <hip/hip_cooperative_groups.h>
#include <cstdio>
#include <cstdint>
namespace cg = cooperative_groups;
#ifndef PROBE_SUB
#define PROBE_SUB 0
#endif

#define LAS __attribute__((address_space(3)))
#define DI __device__ __forceinline__
typedef unsigned short bf16_t;
typedef __attribute__((address_space(1))) unsigned short gbf16_t;
typedef short bf16x8 __attribute__((ext_vector_type(8)));
typedef short s16x4 __attribute__((ext_vector_type(4)));
typedef float f32x4 __attribute__((ext_vector_type(4)));
typedef float f32x16 __attribute__((ext_vector_type(16)));
typedef unsigned u32x4 __attribute__((ext_vector_type(4)));
typedef unsigned u32x2 __attribute__((ext_vector_type(2)));
typedef float f32x2_t __attribute__((ext_vector_type(2)));
typedef __bf16 bf16x2_t __attribute__((ext_vector_type(2)));

constexpr int BATCH = 16, SEQ = 2048, DM = 1024, FF = 2816, TOK = BATCH * SEQ;
constexpr int LD0 = 2816;
constexpr int LD1 = 2304;
constexpr int NIN0 = 2720, NIN1 = 2072;
constexpr int Z0_DIL = 416, Z0_MIX = 1952;
constexpr float EPS = 1e-6f, LOG2E = 1.4426950408889634f;
constexpr int T5RB = 2084;
constexpr int TABW = 2120;

constexpr size_t MiB = 1u << 20;
constexpr size_t WS_WGU = 0;
constexpr size_t WS_WDN = 44 * MiB;
constexpr size_t WS_WIN0 = 66 * MiB;
constexpr size_t WS_WOUT0 = WS_WIN0 + 5632 * 1024;
constexpr size_t WS_WIN1 = 73 * MiB;
constexpr size_t WS_WOUT1 = WS_WIN1 + 4608 * 1024;
constexpr size_t WS_WQB = 80 * MiB;
constexpr size_t WS_WKVB = WS_WQB + 512 * 1024;
constexpr size_t WS_WC1 = 81 * MiB;
constexpr size_t WS_WC2 = 82 * MiB;
constexpr size_t WS_SMALL = 84 * MiB;
constexpr size_t WS_RSS = 508 * MiB;
constexpr size_t WS_T5 = WS_SMALL + 1 * MiB;
constexpr size_t WS_ROPE = WS_SMALL + 2 * MiB;
constexpr size_t WS_CB = WS_SMALL + 3 * MiB;
constexpr size_t WS_KC = WS_SMALL + 4 * MiB;
constexpr size_t WS_VCT = WS_SMALL + 5 * MiB;
constexpr size_t WS_XB = 92 * MiB;
constexpr size_t WS_H = 156 * MiB;
constexpr size_t WS_A = 332 * MiB;
constexpr size_t WS_KM = WS_A;
constexpr size_t WS_VMT = WS_A + 48 * MiB;
constexpr size_t WS_VDT = WS_A + 80 * MiB;
constexpr size_t WS_QM = WS_A + 128 * MiB;
constexpr size_t OUT_OG = 0;
constexpr size_t OUT_LSE = 48 * MiB;
constexpr size_t WS_VT1 = WS_A;
constexpr size_t WS_MIX1 = WS_A + 32 * MiB;
constexpr size_t WS_END = 512 * MiB;

struct Args { const float* in[31]; float* out; unsigned char* ws; int ph_lo, ph_hi; };
typedef const __attribute__((address_space(4))) unsigned char* kptr_t;
struct KA {
    kptr_t k; unsigned char* ws; unsigned char* outb;
    __device__ __forceinline__ const float* in(int i) const { return *(const float* const __attribute__((address_space(4)))*)(k + 8 * i); }
};

DI unsigned cvtpk(float lo, float hi) { f32x2_t v = {lo, hi}; bf16x2_t b = __builtin_convertvector(v, bf16x2_t); return __builtin_bit_cast(unsigned, b); }
DI float bf2f(unsigned short u) { return __uint_as_float(((unsigned)u) << 16); }
DI float bflo(unsigned u) { return __uint_as_float(u << 16); }
DI float bfhi(unsigned u) { return __uint_as_float(u & 0xffff0000u); }
DI float fexp2(float x) { return __builtin_amdgcn_exp2f(x); }
DI float frcp(float x) { return __builtin_amdgcn_rcpf(x); }
DI int crow(int i, int h) { return (i & 3) + 8 * (i >> 2) + 4 * h; }
DI float max3f(float a, float b, float c) { float r; asm("v_max3_f32 %0, %1, %2, %3" : "=v"(r) : "v"(a), "v"(b), "v"(c)); return r; }
DI float max2f(float a, float b) { float r; asm("v_max_f32_e32 %0, %1, %2" : "=v"(r) : "v"(a), "v"(b)); return r; }
#define MFMA32(a, b, c) __builtin_amdgcn_mfma_f32_32x32x16_bf16((a), (b), (c), 0, 0, 0)

namespace pg8 {
constexpr int BM = 256, BK = 64, HALF = 128, HTB = HALF * BK * 2, STAGE_BYTES = 8 * HTB, NXCD = 8, WGM = 8;
DI int lds_byte(int r, int c) { const int st = (r >> 4) * 2 + (c >> 5), rr = r & 15, cc = c & 31, ob = rr * 64 + cc * 2; return st * 1024 + (ob ^ (((ob >> 9) & 1) << 5)); }
DI void stage_rc(int b, int& R, int& C) { const int st = b / 1024, sb = b % 1024, swz = sb ^ (((sb >> 9) & 1) << 5); R = (st >> 1) * 16 + swz / 64; C = (st & 1) * 32 + (swz % 64) / 2; }
DI int perm32(int rho) { const int n = rho >> 4, i = rho & 15; return 8 * (i >> 2) + 4 * n + (i & 3); }
struct Unit { int pm, pn; };
struct Gemm { const bf16_t* A; const bf16_t* Bt; int M, N, K, lda; };
struct StaticOrder {
    int nM, nN, nwg, G, c;
    DI void init(int M, int N, int G_, int c_) { nM = M / BM; nN = N / BM; nwg = nM * nN; G = G_; c = c_; }
    DI bool next(int i, Unit& u) const {
        const long L = (long)i * G + c; if (L >= nwg) return false;
        int wgid = (int)L; { const int q = nwg / NXCD, r = nwg % NXCD, xcd = wgid % NXCD, off = wgid / NXCD; wgid = (xcd < r ? xcd * (q + 1) : r * (q + 1) + (xcd - r) * q) + off; }
        const int nig = WGM * nN, gid = wgid / nig, fm = gid * WGM, gsz = (nM - fm) < WGM ? (nM - fm) : WGM;
        u.pm = fm + ((wgid % nig) % gsz); u.pn = (wgid % nig) / gsz; return true;
    }
};

DI float rss_sum(const float* rss, int row) {
    const f32x4* p = (const f32x4*)(rss + (size_t)row * 16); const f32x4 a = p[0], b = p[1], c = p[2], d = p[3];
    return (((a.x + a.y) + (a.z + a.w)) + ((b.x + b.y) + (b.z + b.w))) + (((c.x + c.y) + (c.z + c.w)) + ((d.x + d.y) + (d.z + d.w))); }
DI void row_rstd8(const float* rss, int row0, int lane, int fq, float (&rs)[8]) {
    float v[2];
#pragma unroll
    for (int e = 0; e < 2; ++e) { const int p = 2 * fq + e; const int row = row0 + (p >> 2) * 128 + (p & 3) * 16; v[e] = 1.0f / sqrtf(rss_sum(rss, row) * (1.0f / DM) + EPS); }
    const int fr = lane & 15;
#pragma unroll
    for (int q = 0; q < 4; ++q) { rs[2 * q] = __shfl(v[0], fr + 16 * q); rs[2 * q + 1] = __shfl(v[1], fr + 16 * q); }
}
struct EpiSwiglu {
    const float* rss; bf16_t* H;
    DI void operator()(const f32x4 (&acc)[2][2][4][2], const Unit& u, int wr, int wc, int fr, int fq) const {
        const int row0 = u.pm * BM + wr * 64 + fr, col = u.pn * 128 + wc * 32 + 8 * fq;
        float rs8[8]; row_rstd8(rss, row0, fr + 16 * fq, fq, rs8);
#pragma unroll
        for (int ai = 0; ai < 2; ++ai)
#pragma unroll
            for (int m = 0; m < 4; ++m) {
                const int row = row0 + ai * HALF + m * 16;
                const float rstd = rs8[ai * 4 + m];
                float hv[8];
#pragma unroll
                for (int n = 0; n < 2; ++n)
#pragma unroll
                    for (int j = 0; j < 4; j += 2) {
                        const float g0 = acc[ai][0][m][n][j] * rstd, u0 = acc[ai][1][m][n][j] * rstd, g1 = acc[ai][0][m][n][j + 1] * rstd, u1 = acc[ai][1][m][n][j + 1] * rstd;
                        const float d0 = 1.0f + fexp2(fminf(-g0 * LOG2E, 60.0f)), d1 = 1.0f + fexp2(fminf(-g1 * LOG2E, 60.0f));
                        const float rp = frcp(d0 * d1);
                        hv[4 * n + j] = g0 * (d1 * rp) * u0; hv[4 * n + j + 1] = g1 * (d0 * rp) * u1;
                    }
                u32x4 w; w.x = cvtpk(hv[0], hv[1]); w.y = cvtpk(hv[2], hv[3]); w.z = cvtpk(hv[4], hv[5]); w.w = cvtpk(hv[6], hv[7]);
                *(u32x4*)(H + (size_t)row * FF + col) = w;
            }
    }
};
struct EpiResid {
    const float* base; const bf16_t* baseb; float* out; bf16_t* xb; float* rss; float alpha;
    DI void operator()(const f32x4 (&acc)[2][2][4][2], const Unit& u, int wr, int wc, int fr, int fq) const {
        const int row0 = u.pm * BM + wr * 64 + fr, col0 = u.pn * BM + wc * 32 + 8 * fq;
        if (baseb) {
            u32x4 bw[2][4][2];
#pragma unroll
            for (int ai = 0; ai < 2; ++ai)
#pragma unroll
                for (int m = 0; m < 4; ++m)
#pragma unroll
                    for (int bj = 0; bj < 2; ++bj) bw[ai][m][bj] = *(const u32x4*)(baseb + (size_t)(row0 + ai * HALF + m * 16) * DM + col0 + bj * HALF);
#pragma unroll
            for (int ai = 0; ai < 2; ++ai)
#pragma unroll
                for (int m = 0; m < 4; ++m) {
                    const int row = row0 + ai * HALF + m * 16; float ss = 0.f;
#pragma unroll
                    for (int bj = 0; bj < 2; ++bj) {
                        const size_t off = (size_t)row * DM + col0 + bj * HALF; const u32x4 w = bw[ai][m][bj];
                        const f32x4 b0 = (f32x4){bflo(w.x), bfhi(w.x), bflo(w.y), bfhi(w.y)}, b1 = (f32x4){bflo(w.z), bfhi(w.z), bflo(w.w), bfhi(w.w)};
                        const f32x4 x0 = b0 + alpha * acc[ai][bj][m][0], x1 = b1 + alpha * acc[ai][bj][m][1];
                        if (out) { *(f32x4*)(out + off) = x0; *(f32x4*)(out + off + 4) = x1; }
                        if (xb) { u32x4 o; o.x = cvtpk(x0[0], x0[1]); o.y = cvtpk(x0[2], x0[3]); o.z = cvtpk(x1[0], x1[1]); o.w = cvtpk(x1[2], x1[3]); *(u32x4*)(xb + off) = o; }
                        ss += (x0[0] * x0[0] + x0[1] * x0[1]) + (x0[2] * x0[2] + x0[3] * x0[3]) + (x1[0] * x1[0] + x1[1] * x1[1]) + (x1[2] * x1[2] + x1[3] * x1[3]);
                    }
                    if (rss) { ss += __shfl_xor(ss, 16); ss += __shfl_xor(ss, 32); if (fq == 0) rss[(size_t)row * 16 + u.pn * 4 + wc] = ss; }
                }
            return;
        }
#pragma unroll
        for (int ai = 0; ai < 2; ++ai)
#pragma unroll
            for (int m = 0; m < 4; ++m) {
                const int row = row0 + ai * HALF + m * 16; float ss = 0.f;
#pragma unroll
                for (int bj = 0; bj < 2; ++bj) {
                    const size_t off = (size_t)row * DM + col0 + bj * HALF;
                    const f32x4 b0 = *(const f32x4*)(base + off), b1 = *(const f32x4*)(base + off + 4);
                    const f32x4 x0 = b0 + alpha * acc[ai][bj][m][0], x1 = b1 + alpha * acc[ai][bj][m][1];
                    if (out) { *(f32x4*)(out + off) = x0; *(f32x4*)(out + off + 4) = x1; }
                    if (xb) { u32x4 w; w.x = cvtpk(x0[0], x0[1]); w.y = cvtpk(x0[2], x0[3]); w.z = cvtpk(x1[0], x1[1]); w.w = cvtpk(x1[2], x1[3]); *(u32x4*)(xb + off) = w; }
                    ss += (x0[0] * x0[0] + x0[1] * x0[1]) + (x0[2] * x0[2] + x0[3] * x0[3]) + (x1[0] * x1[0] + x1[1] * x1[1]) + (x1[2] * x1[2] + x1[3] * x1[3]);
                }
                if (rss) { ss += __shfl_xor(ss, 16); ss += __shfl_xor(ss, 32); if (fq == 0) rss[(size_t)row * 16 + u.pn * 4 + wc] = ss; }
                asm volatile("" ::: "memory");
            }
    }
};
struct EpiScale {
    const float* rss; bf16_t* Z; int ldz;
    DI void operator()(const f32x4 (&acc)[2][2][4][2], const Unit& u, int wr, int wc, int fr, int fq) const {
        const int row0 = u.pm * BM + wr * 64 + fr, col0 = u.pn * BM + wc * 32 + 8 * fq;
        float rs8[8]; row_rstd8(rss, row0, fr + 16 * fq, fq, rs8);
#pragma unroll
        for (int ai = 0; ai < 2; ++ai)
#pragma unroll
            for (int m = 0; m < 4; ++m) {
                const int row = row0 + ai * HALF + m * 16;
                const float rstd = rs8[ai * 4 + m];
#pragma unroll
                for (int bj = 0; bj < 2; ++bj) {
                    const f32x4 v0 = acc[ai][bj][m][0] * rstd, v1 = acc[ai][bj][m][1] * rstd;
                    u32x4 w; w.x = cvtpk(v0[0], v0[1]); w.y = cvtpk(v0[2], v0[3]); w.z = cvtpk(v1[0], v1[1]); w.w = cvtpk(v1[2], v1[3]);
                    *(u32x4*)(Z + (size_t)row * ldz + col0 + bj * HALF) = w;
                }
            }
    }
};

template <class Epi>
DI void gemm_phase(LAS unsigned char* lds, const int tid, const Gemm g, const StaticOrder& S, const Epi& E) {
    const int wid = __builtin_amdgcn_readfirstlane(tid >> 6), lane = tid & 63, wr = wid >> 2, wc = wid & 3, fr = lane & 15, fq = lane >> 4;
    const int K = g.K, nt = K / BK, lda = g.lda;
    unsigned voffA[2], voffB[2];
#pragma unroll
    for (int i = 0; i < 2; ++i) { int R, C; stage_rc(tid * 16 + i * 8192, R, C); const int Rb = (R & ~31) + perm32(R & 31);
        voffA[i] = (unsigned)(R * lda + C) * 2u; voffB[i] = (unsigned)(Rb * K + C) * 2u; }
    const size_t kstep = (size_t)(BK * 2);
    const size_t hstepA = (size_t)HALF * lda * 2, hstepB = (size_t)HALF * K * 2;
    const size_t tstepA = 2 * hstepA, tstepB = 2 * hstepB;
    const unsigned ldsw = (unsigned)wid * 1024u;
    const int aoff = lds_byte(wr * 64 + fr, fq * 8), boff = lds_byte(wc * 32 + fr, fq * 8);
#define PG8_SA(b, h) (((b) * 2 + (h)) * HTB)
#define PG8_SB(b, h) ((4 + (b) * 2 + (h)) * HTB)
#define PG8_STAGE(bufoff, gbase, voff) do { _Pragma("unroll") for (int _i = 0; _i < 2; ++_i) \
        __builtin_amdgcn_global_load_lds((const unsigned*)((const char*)(gbase) + (voff)[_i]), (LAS unsigned*)(lds + (bufoff) + ldsw + _i * 8192), 16, 0, 0); } while (0)
#define PG8_LDA(dst, b, h) do { _Pragma("unroll") for (int m = 0; m < 4; ++m) _Pragma("unroll") for (int k = 0; k < 2; ++k) dst[m][k] = *(const LAS bf16x8*)(lds + PG8_SA(b, h) + aoff + m * 2048 + k * 1024); } while (0)
#define PG8_LDB(dst, b, h) do { _Pragma("unroll") for (int n = 0; n < 2; ++n) _Pragma("unroll") for (int k = 0; k < 2; ++k) dst[n][k] = *(const LAS bf16x8*)(lds + PG8_SB(b, h) + boff + n * 2048 + k * 1024); } while (0)
#define PG8_MMA(ai, bj, At, Bt) do { __builtin_amdgcn_s_setprio(1); _Pragma("unroll") for (int m = 0; m < 4; ++m) _Pragma("unroll") for (int n = 0; n < 2; ++n) _Pragma("unroll") for (int k = 0; k < 2; ++k) \
        acc[ai][bj][m][n] = __builtin_amdgcn_mfma_f32_16x16x32_bf16(Bt[n][k], At[m][k], acc[ai][bj][m][n], 0, 0, 0); __builtin_amdgcn_s_setprio(0); } while (0)
#define PG8_WAIT_V(n) asm volatile("s_waitcnt vmcnt(" #n ")" ::: "memory")
#define PG8_WAIT_L(n) asm volatile("s_waitcnt lgkmcnt(" #n ")" ::: "memory")
#define PG8_BAR __builtin_amdgcn_s_barrier()
#define PG8_SCHED __builtin_amdgcn_sched_barrier(0)
    Unit cur, nxt; int ui = 0;
    if (!S.next(0, cur)) return;
    f32x4 acc[2][2][4][2];
#pragma unroll
    for (int a = 0; a < 2; ++a)
#pragma unroll
        for (int b = 0; b < 2; ++b)
#pragma unroll
            for (int m = 0; m < 4; ++m)
#pragma unroll
                for (int n = 0; n < 2; ++n) acc[a][b][m][n] = (f32x4){0.f, 0.f, 0.f, 0.f};
    bf16x8 At[4][2], B0[2][2], B1[2][2];
    const char* cA = (const char*)g.A + (size_t)cur.pm * tstepA; const char* cB = (const char*)g.Bt + (size_t)cur.pn * tstepB;
    PG8_STAGE(PG8_SB(0, 0), cB, voffB); PG8_STAGE(PG8_SB(0, 1), cB + hstepB, voffB); PG8_STAGE(PG8_SA(0, 0), cA, voffA); PG8_STAGE(PG8_SA(0, 1), cA + hstepA, voffA);
    if (wr == 1) PG8_BAR;
    PG8_WAIT_V(2); PG8_BAR;
    PG8_STAGE(PG8_SB(1, 0), cB + kstep, voffB); PG8_STAGE(PG8_SA(1, 0), cA + kstep, voffA); PG8_STAGE(PG8_SB(1, 1), cB + hstepB + kstep, voffB);
    PG8_WAIT_V(6); PG8_BAR;
    for (;;) {
        const bool has_next = S.next(ui + 1, nxt);
        const char* nA = has_next ? (const char*)g.A + (size_t)nxt.pm * tstepA : cA; const char* nB = has_next ? (const char*)g.Bt + (size_t)nxt.pn * tstepB : cB;
        for (int t = 0; t < nt; t += 2) {
            const bool last = (t == nt - 2);
            const char* a1 = cA + (size_t)(t + 1) * kstep;
            const char* a2 = last ? nA : cA + (size_t)(t + 2) * kstep; const char* b2 = last ? nB : cB + (size_t)(t + 2) * kstep;
            const char* a3 = a2 + kstep; const char* b3 = b2 + kstep;
            PG8_LDB(B0, 0, 0); PG8_LDB(B1, 0, 1); PG8_SCHED; PG8_LDA(At, 0, 0); PG8_STAGE(PG8_SA(1, 1), a1 + hstepA, voffA);
            PG8_WAIT_V(8); PG8_WAIT_L(0); PG8_BAR; PG8_MMA(0, 0, At, B0); PG8_MMA(0, 1, At, B1); PG8_BAR; PG8_SCHED;
            PG8_LDA(At, 0, 1); PG8_STAGE(PG8_SB(0, 0), b2, voffB); PG8_STAGE(PG8_SB(0, 1), b2 + hstepB, voffB); PG8_STAGE(PG8_SA(0, 0), a2, voffA);
            PG8_WAIT_V(8); PG8_WAIT_L(0); PG8_BAR; PG8_MMA(1, 0, At, B0); PG8_MMA(1, 1, At, B1); PG8_BAR; PG8_SCHED;
            PG8_LDB(B0, 1, 0); PG8_LDB(B1, 1, 1); PG8_SCHED; PG8_LDA(At, 1, 0); PG8_STAGE(PG8_SA(0, 1), a2 + hstepA, voffA);
            PG8_WAIT_V(8); PG8_WAIT_L(0); PG8_BAR; PG8_MMA(0, 0, At, B0); PG8_MMA(0, 1, At, B1); PG8_BAR; PG8_SCHED;
            PG8_LDA(At, 1, 1); PG8_STAGE(PG8_SB(1, 0), b3, voffB); PG8_STAGE(PG8_SB(1, 1), b3 + hstepB, voffB); PG8_STAGE(PG8_SA(1, 0), a3, voffA);
            PG8_WAIT_V(8); PG8_WAIT_L(0); PG8_BAR; PG8_MMA(1, 0, At, B0); PG8_MMA(1, 1, At, B1); PG8_BAR; PG8_SCHED;
        }
        if (wr == 0) PG8_BAR;
        E(acc, cur, wr, wc, fr, fq);
        if (!has_next) break;
#pragma unroll
        for (int a = 0; a < 2; ++a)
#pragma unroll
            for (int b = 0; b < 2; ++b)
#pragma unroll
                for (int m = 0; m < 4; ++m)
#pragma unroll
                    for (int n = 0; n < 2; ++n) acc[a][b][m][n] = (f32x4){0.f, 0.f, 0.f, 0.f};
        cur = nxt; cA = nA; cB = nB; ++ui;
        if (wr == 1) PG8_BAR;
    }
    PG8_WAIT_V(0);
    PG8_BAR;
#undef PG8_SA
#undef PG8_SB
#undef PG8_STAGE
#undef PG8_LDA
#undef PG8_LDB
#undef PG8_MMA
}
}

struct Ctx {
    LAS unsigned char* lds;
    int tid, lane, wave, n, h;
    int gw, NGW, G;
};

DI int t5_bucket(int n) {
    if (n < 16) return n;
    const int v = 16 + (int)(__builtin_amdgcn_logf((float)n * 0.0625f) * (16.0f / 7.0f));
    return v < 31 ? v : 31;
}

DI void transpose_item(const float* __restrict__ W, int K, int N, bf16_t* WT, int ldw, int row_base, const float* __restrict__ gain, LAS float* scr, int item, int lane) {
    const int nblk = (N + 31) / 32, kb = item / nblk, nb = item % nblk, k0 = 64 * kb, n0 = 32 * nb;
    float tv[32];
#pragma unroll
    for (int i = 0; i < 32; ++i) { const int kk = 2 * i + (lane >> 5), nn = n0 + (lane & 31); tv[i] = (nn < N) ? W[(size_t)(k0 + kk) * N + nn] : 0.f; }
#pragma unroll
    for (int i = 0; i < 32; ++i) { const int kk = 2 * i + (lane >> 5); float v = tv[i]; if (gain) v *= gain[k0 + kk]; scr[kk * 33 + (lane & 31)] = v; }
    asm volatile("s_waitcnt lgkmcnt(0)" ::: "memory");
    const int c = lane & 7;
#pragma unroll
    for (int j = 0; j < 4; ++j) { const int nl = (lane >> 3) + 8 * j; const LAS float* s = scr + (8 * c) * 33 + nl;
        u32x4 o; o.x = cvtpk(s[0 * 33], s[1 * 33]); o.y = cvtpk(s[2 * 33], s[3 * 33]); o.z = cvtpk(s[4 * 33], s[5 * 33]); o.w = cvtpk(s[6 * 33], s[7 * 33]);
        *(u32x4*)(WT + (size_t)(row_base + nl) * ldw + k0 + 8 * c) = o; }
    asm volatile("s_waitcnt lgkmcnt(0)" ::: "memory");
}

DI void phase_prologue(const Ctx& C, const KA& a) {
    unsigned char* ws = a.ws;
    LAS float* scr = (LAS float*)(C.lds + C.wave * 8704);
    const int I_GU = 16 * 88, I_DN = 44 * 32, I_IN0 = 16 * 85, I_OUT0 = 12 * 32, I_IN1 = 16 * 65, I_OUT1 = 16 * 32, I_QB = 4 * 24, I_KVB = 2 * 32, I_C1 = 32 * 4, I_C2 = 2 * 2;
    const int NIT = 8 * I_GU + 4 * I_DN + I_IN0 + I_OUT0 + I_IN1 + I_OUT1 + I_QB + I_KVB + 2 * I_C1 + 2 * I_C2;
    for (int prep_ = 0; prep_ < ((PROBE_SUB == 6) ? 2 : 1); ++prep_)
    for (int it = C.gw; it < NIT; it += C.NGW) {
        int r = it;
        if (r < 8 * I_GU) {
            const int mat = r / I_GU, item = r % I_GU, l = mat >> 2, f = (mat >> 1) & 1, up = mat & 1;
            const float* W = a.in(f ? (up ? 9 : 8) : (up ? 4 : 3)) + (size_t)l * DM * FF;
            const float* gn = a.in(f ? 7 : 2) + l * DM;
            const int nb = item % 88, n0 = 32 * nb;
            bf16_t* WT = (bf16_t*)(ws + WS_WGU) + (size_t)(l * 2 + f) * 5632 * 1024;
            transpose_item(W, DM, FF, WT, DM, (n0 >> 7) * 256 + up * 128 + (n0 & 127), gn, scr, item, C.lane);
            continue;
        }
        r -= 8 * I_GU;
        if (r < 4 * I_DN) { const int mat = r / I_DN, item = r % I_DN, l = mat >> 1, f = mat & 1;
            const float* W = a.in(f ? 10 : 5) + (size_t)l * FF * DM;
            bf16_t* WT = (bf16_t*)(ws + WS_WDN) + (size_t)(l * 2 + f) * 1024 * FF;
            transpose_item(W, FF, DM, WT, FF, 32 * (item % 32), nullptr, scr, item, C.lane); continue; }
        r -= 4 * I_DN;
        if (r < I_IN0) { transpose_item(a.in(11), DM, NIN0, (bf16_t*)(ws + WS_WIN0), DM, 32 * (r % 85), a.in(6), scr, r, C.lane); continue; }
        r -= I_IN0;
        if (r < I_OUT0) { transpose_item(a.in(20), 768, DM, (bf16_t*)(ws + WS_WOUT0), 768, 32 * (r % 32), nullptr, scr, r, C.lane); continue; }
        r -= I_OUT0;
        if (r < I_IN1) { transpose_item(a.in(21), DM, NIN1, (bf16_t*)(ws + WS_WIN1), DM, 32 * (r % 65), a.in(6) + DM, scr, r, C.lane); continue; }
        r -= I_IN1;
        if (r < I_OUT1) { transpose_item(a.in(30), DM, DM, (bf16_t*)(ws + WS_WOUT1), DM, 32 * (r % 32), nullptr, scr, r, C.lane); continue; }
        r -= I_OUT1;
        if (r < I_QB) { transpose_item(a.in(13), 256, 768, (bf16_t*)(ws + WS_WQB), 256, 32 * (r % 24), a.in(12), scr, r, C.lane); continue; }
        r -= I_QB;
        if (r < I_KVB) { transpose_item(a.in(15), 128, 1024, (bf16_t*)(ws + WS_WKVB), 128, 32 * (r % 32), a.in(14), scr, r, C.lane); continue; }
        r -= I_KVB;
        if (r < 2 * I_C1) { const int w = r / I_C1, item = r % I_C1;
            transpose_item(a.in(28) + (size_t)w * 2048 * 128, 2048, 128, (bf16_t*)(ws + WS_WC1) + (size_t)w * 128 * 2048, 2048, 32 * (item % 4), nullptr, scr, item, C.lane); continue; }
        r -= 2 * I_C1;
        { const int w = r / I_C2, item = r % I_C2;
            transpose_item(a.in(29) + (size_t)w * 128 * 64, 128, 64, (bf16_t*)(ws + WS_WC2) + (size_t)w * 64 * 128, 128, 32 * (item % 2), nullptr, scr, item, C.lane); }
    }
    {
        const float* x = a.in(0); bf16_t* xb = (bf16_t*)(ws + WS_XB); float* rss = (float*)(ws + WS_RSS);
        for (int prep_ = 0; prep_ < ((PROBE_SUB == 7) ? 2 : 1); ++prep_)
        for (int m0 = 2 * C.gw; m0 < TOK; m0 += 2 * C.NGW) {
            f32x4 v[2][4];
#pragma unroll
            for (int rr = 0; rr < 2; ++rr) { const f32x4* xr = (const f32x4*)(x + (size_t)(m0 + rr) * DM) + C.lane;
#pragma unroll
                for (int j = 0; j < 4; ++j) v[rr][j] = xr[64 * j]; }
#pragma unroll
            for (int rr = 0; rr < 2; ++rr) { const int m = m0 + rr; float s = 0.f;
                unsigned long long* o8 = (unsigned long long*)(xb + (size_t)m * DM) + C.lane;
#pragma unroll
                for (int j = 0; j < 4; ++j) { const f32x4 w = v[rr][j]; s += (w.x * w.x + w.y * w.y) + (w.z * w.z + w.w * w.w);
                    o8[64 * j] = (unsigned long long)cvtpk(w.x, w.y) | ((unsigned long long)cvtpk(w.z, w.w) << 32); }
#pragma unroll
                for (int o = 1; o < 64; o <<= 1) s += __shfl_xor(s, o);
                if (C.lane < 16) rss[(size_t)m * 16 + C.lane] = (C.lane == 0) ? s : 0.f; }
        }
        const int gt = C.gw * 64 + C.lane, NT = C.NGW * 64;
        float* t5 = (float*)(ws + WS_T5); const float* rb = a.in(1);
        for (int i = gt; i < 16 * TABW; i += NT) { const int col = i / TABW, d = T5RB - i % TABW; float v = 0.f; if (d >= 0 && d <= 2048) v = rb[t5_bucket(d) * 16 + col] * LOG2E; t5[i] = v; }
        float* rope = (float*)(ws + WS_ROPE);
        for (int i = gt; i < 2048 * 16; i += NT) { const int t = i >> 4, f = i & 15; const float inv = fexp2(-(float)f * (13.287712379549449f / 16.0f)); const float ang = (float)t * inv;
            const double rev = (double)ang * 0.15915494309189535; const float fr = (float)(rev - __builtin_rint(rev));
            rope[2 * i] = __builtin_amdgcn_cosf(fr); rope[2 * i + 1] = __builtin_amdgcn_sinf(fr); }
        float* cb = (float*)(ws + WS_CB);
        for (int o = C.gw; o < 256; o += C.NGW) { const int w = o >> 7, j = o & 127; const float* pos = a.in(27) + w * 2048; const float* w1 = a.in(28) + (size_t)w * 2048 * 128; float sacc = 0.f;
#pragma unroll 8
            for (int k = C.lane; k < 2048; k += 64) sacc += pos[k] * w1[(size_t)k * 128 + j];
#pragma unroll
            for (int off = 1; off < 64; off <<= 1) sacc += __shfl_xor(sacc, off);
            if (C.lane == 0) cb[o] = sacc; }
    }
}

template <int DK, int DSC, bool BIAS, bool SEL, bool LOCK = false>
DI void attn_tiles(f32x16& o0, f32x16& o1, float& m, float& l, const bf16x8 (&qf)[DK / 16], const char* kl, size_t kstride, const char* vl, size_t vstride,
                   int kt_lo, int kt_hi, int tq, int W, const LAS float* tab, unsigned selw, int h, int blk_lo = 0, int blk_hi = 0) {
    if (LOCK) { for (int kt = blk_lo; kt < kt_lo; ++kt) __builtin_amdgcn_s_barrier(); }
    bf16x8 kf[DK / 16]; s16x4 va[8];
    {
        const char* kp = kl + (size_t)(32 * kt_lo) * kstride;
#pragma unroll
        for (int ks = 0; ks < DK / 16; ++ks) kf[ks] = *(const bf16x8*)(kp + ks * 32);
        const char* vp = vl + (size_t)(32 * kt_lo) * 2; const char* vp2 = vp + 32 * vstride;
#pragma unroll
        for (int j = 0; j < 4; ++j) { va[j] = *(const s16x4*)(vp + 16 * j); va[4 + j] = *(const s16x4*)(vp2 + 16 * j); }
    }
#pragma unroll 1
    for (int kt = kt_lo; kt <= kt_hi; ++kt) {
        const int k0 = 32 * kt;
        if (LOCK) __builtin_amdgcn_s_barrier();
        f32x16 s;
#pragma unroll
        for (int i = 0; i < 16; ++i) s[i] = 0.f;
#pragma unroll
        for (int ks = 0; ks < DK / 16; ++ks) s = MFMA32(kf[ks], qf[ks], s);
        __builtin_amdgcn_sched_barrier(0);
        s16x4 vb[8];
        {
            const int ktn = (kt < kt_hi) ? kt + 1 : kt_hi;
            const char* kp = kl + (size_t)(32 * ktn) * kstride;
#pragma unroll
            for (int ks = 0; ks < DK / 16; ++ks) kf[ks] = *(const bf16x8*)(kp + ks * 32);
            const char* vp = vl + (size_t)(32 * ktn) * 2; const char* vp2 = vp + 32 * vstride;
#pragma unroll
            for (int j = 0; j < 4; ++j) { vb[j] = *(const s16x4*)(vp + 16 * j); vb[4 + j] = *(const s16x4*)(vp2 + 16 * j); }
        }
        asm volatile("" ::: "memory");
        __builtin_amdgcn_sched_barrier(0);
        const int dbase = tq - k0 - 4 * h;
        const bool selok = SEL ? (((selw >> (kt >> 1)) & 1u) != 0u) : true;
        const LAS float* tb = tab + (dbase - 27) * DSC;
        float mx = -INFINITY;
#pragma unroll
        for (int i = 0; i < 16; ++i) {
            const int c = (i & 3) + 8 * (i >> 2); const int delta = dbase - c;
            float v = s[i]; if (BIAS) v += tb[(27 - c) * DSC];
            v = ((unsigned)delta < (unsigned)W && selok) ? v : -INFINITY; s[i] = v; mx = fmaxf(mx, v);
        }
        mx = fmaxf(mx, __shfl_xor(mx, 32));
        const float mn = fmaxf(m, mx), mu = (mn == -INFINITY) ? 0.f : mn;
        const float alpha = fexp2(m - mu); m = mn;
        float rs = 0.f;
#pragma unroll
        for (int i = 0; i < 16; ++i) { s[i] = fexp2(s[i] - mu); rs += s[i]; }
        l = l * alpha + rs;
#pragma unroll
        for (int i = 0; i < 16; ++i) { o0[i] *= alpha; o1[i] *= alpha; }
        u32x4 p0, p1;
        p0.x = cvtpk(s[0], s[1]); p0.y = cvtpk(s[2], s[3]); p0.z = cvtpk(s[4], s[5]); p0.w = cvtpk(s[6], s[7]);
        p1.x = cvtpk(s[8], s[9]); p1.y = cvtpk(s[10], s[11]); p1.z = cvtpk(s[12], s[13]); p1.w = cvtpk(s[14], s[15]);
        const bf16x8 pb0 = __builtin_bit_cast(bf16x8, p0), pb1 = __builtin_bit_cast(bf16x8, p1);
        o0 = MFMA32(__builtin_shufflevector(va[0], va[1], 0, 1, 2, 3, 4, 5, 6, 7), pb0, o0);
        o0 = MFMA32(__builtin_shufflevector(va[2], va[3], 0, 1, 2, 3, 4, 5, 6, 7), pb1, o0);
        o1 = MFMA32(__builtin_shufflevector(va[4], va[5], 0, 1, 2, 3, 4, 5, 6, 7), pb0, o1);
        o1 = MFMA32(__builtin_shufflevector(va[6], va[7], 0, 1, 2, 3, 4, 5, 6, 7), pb1, o1);
        __builtin_amdgcn_sched_barrier(0);
#pragma unroll
        for (int j = 0; j < 8; ++j) va[j] = vb[j];
    }
    if (LOCK) { for (int kt = kt_hi + 1; kt <= blk_hi; ++kt) __builtin_amdgcn_s_barrier(); }
}

DI void load_q64(bf16x8 (&qf)[4], const bf16_t* qrow, const float* __restrict__ gain, float scale, int h) {
    u32x4 raw[4]; float ss = 0.f;
#pragma unroll
    for (int ks = 0; ks < 4; ++ks) { raw[ks] = *(const u32x4*)(qrow + 16 * ks + 8 * h);
#pragma unroll
        for (int j = 0; j < 4; ++j) { const float a = bflo(raw[ks][j]), b = bfhi(raw[ks][j]); ss += a * a + b * b; } }
    ss += __shfl_xor(ss, 32);
    const float r = scale / sqrtf(ss * (1.0f / 64.0f) + EPS);
#pragma unroll
    for (int ks = 0; ks < 4; ++ks) { u32x4 w; const f32x4 g0 = *(const f32x4*)(gain + 16 * ks + 8 * h), g1 = *(const f32x4*)(gain + 16 * ks + 8 * h + 4);
        w.x = cvtpk(bflo(raw[ks].x) * r * g0.x, bfhi(raw[ks].x) * r * g0.y); w.y = cvtpk(bflo(raw[ks].y) * r * g0.z, bfhi(raw[ks].y) * r * g0.w);
        w.z = cvtpk(bflo(raw[ks].z) * r * g1.x, bfhi(raw[ks].z) * r * g1.y); w.w = cvtpk(bflo(raw[ks].w) * r * g1.z, bfhi(raw[ks].w) * r * g1.w);
        qf[ks] = __builtin_bit_cast(bf16x8, w); }
}

DI void zero16(f32x16& v) {
#pragma unroll
    for (int i = 0; i < 16; ++i) v[i] = 0.f;
}
DI void store_o64(bf16_t* dst, const f32x16& o0, const f32x16& o1, float sc, int h) {
#pragma unroll
    for (int q = 0; q < 4; ++q) {
        u32x2 w; w.x = cvtpk(o0[4 * q] * sc, o0[4 * q + 1] * sc); w.y = cvtpk(o0[4 * q + 2] * sc, o0[4 * q + 3] * sc);
        *(u32x2*)(dst + 8 * q + 4 * h) = w;
        u32x2 w2; w2.x = cvtpk(o1[4 * q] * sc, o1[4 * q + 1] * sc); w2.y = cvtpk(o1[4 * q + 2] * sc, o1[4 * q + 3] * sc);
        *(u32x2*)(dst + 32 + 8 * q + 4 * h) = w2;
    }
}

DI int deal(int it, int gw, int NGW, int total) {
    int pos = gw; if (it & 1) pos = NGW - 1 - gw;
    const long e = (long)it * NGW + pos; return e < total ? (int)e : -1;
}

DI void mla_prep_item(const Ctx& C, const KA& a, int item) {
    unsigned char* ws = a.ws;
    int ln_ = C.lane; asm volatile("" : "+v"(ln_));
    const int tt = item >> 2, part = item & 3, n = ln_ & 31, h = ln_ >> 5;
    const int tok = tt * 32 + n, b = tok >> 11, t = tok & 2047;
    const bf16_t* zr = (const bf16_t*)(ws + WS_H) + (size_t)tok * LD0;
    const bf16_t* Wqb = (const bf16_t*)(ws + WS_WQB); const bf16_t* Wkvb = (const bf16_t*)(ws + WS_WKVB);
    const float* rope = (const float*)(ws + WS_ROPE) + (size_t)t * 32;
    bf16x8 cq[16];
    {
        u32x4 raw[16]; float ss = 0.f;
#pragma unroll
        for (int ks = 0; ks < 16; ++ks) { raw[ks] = *(const u32x4*)(zr + 16 * ks + 8 * h);
#pragma unroll
            for (int j = 0; j < 4; ++j) { const float x = bflo(raw[ks][j]), y = bfhi(raw[ks][j]); ss += x * x + y * y; } }
        ss += __shfl_xor(ss, 32);
        const float r = 1.0f / sqrtf(ss * (1.0f / 256.0f) + EPS);
#pragma unroll
        for (int ks = 0; ks < 16; ++ks) { u32x4 w;
#pragma unroll
            for (int j = 0; j < 4; ++j) w[j] = cvtpk(bflo(raw[ks][j]) * r, bfhi(raw[ks][j]) * r);
            cq[ks] = __builtin_bit_cast(bf16x8, w); }
    }
    const float* qg = a.in(16); const float* kg = a.in(17);
    bf16_t* qm = (bf16_t*)(ws + WS_QM); bf16_t* km = (bf16_t*)(ws + WS_KM); bf16_t* vmT = (bf16_t*)(ws + WS_VMT);
    const float qscale = 0.10206207261596575f * LOG2E;
#pragma unroll 1
    for (int hh = 0; hh < 2; ++hh) {
        const int head = part * 2 + hh;
        f32x16 acc3[3];
#pragma unroll
        for (int ft = 0; ft < 3; ++ft) { zero16(acc3[ft]); const bf16_t* wr = Wqb + (size_t)(head * 96 + 32 * ft + n) * 256 + 8 * h;
#pragma unroll
            for (int k8 = 0; k8 < 16; k8 += 8) { bf16x8 wa[8];
#pragma unroll
                for (int j = 0; j < 8; ++j) wa[j] = *(const bf16x8*)(wr + 16 * (k8 + j));
#pragma unroll
                for (int j = 0; j < 8; ++j) acc3[ft] = MFMA32(wa[j], cq[k8 + j], acc3[ft]);
                asm volatile("" ::: "memory"); } }
        float ss = 0.f;
#pragma unroll
        for (int ft = 0; ft < 3; ++ft)
#pragma unroll
            for (int i = 0; i < 16; ++i) ss += acc3[ft][i] * acc3[ft][i];
        ss += __shfl_xor(ss, 32);
        const float r = qscale / sqrtf(ss * (1.0f / 96.0f) + EPS);
        bf16_t* dst = qm + ((size_t)(b * 8 + head) * SEQ + t) * 96;
#pragma unroll
        for (int ft = 0; ft < 2; ++ft)
#pragma unroll
            for (int q = 0; q < 4; ++q) { const int f = 32 * ft + 8 * q + 4 * h; const f32x4 g = *(const f32x4*)(qg + f);
                u32x2 w; w.x = cvtpk(acc3[ft][4 * q] * r * g.x, acc3[ft][4 * q + 1] * r * g.y); w.y = cvtpk(acc3[ft][4 * q + 2] * r * g.z, acc3[ft][4 * q + 3] * r * g.w);
                *(u32x2*)(dst + f) = w; }
#pragma unroll
        for (int q = 0; q < 2; ++q) { const int f1 = 8 * q + 4 * h; const f32x4 g1 = *(const f32x4*)(qg + 64 + f1), g2 = *(const f32x4*)(qg + 80 + f1);
            float o1[4], o2[4];
#pragma unroll
            for (int j = 0; j < 4; ++j) { const float x1 = acc3[2][4 * q + j] * r * g1[j], x2 = acc3[2][4 * q + 8 + j] * r * g2[j]; const float cs = rope[2 * (f1 + j)], sn = rope[2 * (f1 + j) + 1];
                o1[j] = x1 * cs - x2 * sn; o2[j] = x2 * cs + x1 * sn; }
            u32x2 w; w.x = cvtpk(o1[0], o1[1]); w.y = cvtpk(o1[2], o1[3]); *(u32x2*)(dst + 64 + f1) = w;
            u32x2 w2; w2.x = cvtpk(o2[0], o2[1]); w2.y = cvtpk(o2[2], o2[3]); *(u32x2*)(dst + 80 + f1) = w2; }
    }
    asm volatile("" ::: "memory");
    bf16x8 ckv[8];
    {
        u32x4 raw[8]; float ss = 0.f;
#pragma unroll
        for (int ks = 0; ks < 8; ++ks) { raw[ks] = *(const u32x4*)(zr + 256 + 16 * ks + 8 * h);
#pragma unroll
            for (int j = 0; j < 4; ++j) { const float x = bflo(raw[ks][j]), y = bfhi(raw[ks][j]); ss += x * x + y * y; } }
        ss += __shfl_xor(ss, 32);
        const float r = 1.0f / sqrtf(ss * (1.0f / 128.0f) + EPS);
#pragma unroll
        for (int ks = 0; ks < 8; ++ks) { u32x4 w;
#pragma unroll
            for (int j = 0; j < 4; ++j) w[j] = cvtpk(bflo(raw[ks][j]) * r, bfhi(raw[ks][j]) * r);
            ckv[ks] = __builtin_bit_cast(bf16x8, w); }
    }
    float kr1[8], kr2[8]; float ssr = 0.f;
#pragma unroll
    for (int q = 0; q < 2; ++q) { const u32x2 r1 = *(const u32x2*)(zr + 384 + 8 * q + 4 * h), r2 = *(const u32x2*)(zr + 400 + 8 * q + 4 * h);
        kr1[4 * q] = bflo(r1.x); kr1[4 * q + 1] = bfhi(r1.x); kr1[4 * q + 2] = bflo(r1.y); kr1[4 * q + 3] = bfhi(r1.y);
        kr2[4 * q] = bflo(r2.x); kr2[4 * q + 1] = bfhi(r2.x); kr2[4 * q + 2] = bflo(r2.y); kr2[4 * q + 3] = bfhi(r2.y); }
#pragma unroll
    for (int j = 0; j < 8; ++j) ssr += kr1[j] * kr1[j] + kr2[j] * kr2[j];
    ssr += __shfl_xor(ssr, 32);
#pragma unroll 1
    for (int hh = 0; hh < 2; ++hh) {
        const int head = part * 2 + hh;
        float ss = 0.f;
#pragma unroll 1
        for (int ft = 0; ft < 2; ++ft) { f32x16 acc; zero16(acc); const bf16_t* wr = Wkvb + (size_t)(head * 128 + 32 * ft + n) * 128 + 8 * h;
#pragma unroll
            for (int ks = 0; ks < 8; ++ks) { const bf16x8 wa = *(const bf16x8*)(wr + 16 * ks); acc = MFMA32(wa, ckv[ks], acc); }
#pragma unroll
            for (int i = 0; i < 16; ++i) ss += acc[i] * acc[i]; }
        ss += __shfl_xor(ss, 32);
        const float r = 1.0f / sqrtf((ss + ssr) * (1.0f / 96.0f) + EPS);
        bf16_t* dst = km + ((size_t)(b * 8 + head) * SEQ + t) * 96;
        bf16_t* vd = vmT + ((size_t)(b * 8 + head) * 64 + 4 * h) * SEQ + t;
#pragma unroll 1
        for (int ft = 0; ft < 4; ++ft) { f32x16 acc; zero16(acc); const bf16_t* wr = Wkvb + (size_t)(head * 128 + 32 * ft + n) * 128 + 8 * h;
#pragma unroll
            for (int ks = 0; ks < 8; ++ks) { const bf16x8 wa = *(const bf16x8*)(wr + 16 * ks); acc = MFMA32(wa, ckv[ks], acc); }
            if (ft < 2) {
#pragma unroll
                for (int q = 0; q < 4; ++q) { const int f = 32 * ft + 8 * q + 4 * h; const f32x4 g = *(const f32x4*)(kg + f);
                    u32x2 w; w.x = cvtpk(acc[4 * q] * r * g.x, acc[4 * q + 1] * r * g.y); w.y = cvtpk(acc[4 * q + 2] * r * g.z, acc[4 * q + 3] * r * g.w);
                    *(u32x2*)(dst + f) = w; }
            } else {
                bf16_t* vp_ = vd + (size_t)(32 * (ft - 2)) * SEQ; asm volatile("" : "+v"(vp_)); gbf16_t* vp = (gbf16_t*)vp_;
#pragma unroll
                for (int i = 0; i < 16; ++i) vp[(size_t)crow(i, 0) * SEQ] = (bf16_t)(cvtpk(acc[i], 0.f) & 0xffffu);
            }
        }
#pragma unroll
        for (int q = 0; q < 2; ++q) { const int f1 = 8 * q + 4 * h; const f32x4 g1 = *(const f32x4*)(kg + 64 + f1), g2 = *(const f32x4*)(kg + 80 + f1);
            float o1[4], o2[4];
#pragma unroll
            for (int j = 0; j < 4; ++j) { const float x1 = kr1[4 * q + j] * r * g1[j], x2 = kr2[4 * q + j] * r * g2[j]; const float cs = rope[2 * (f1 + j)], sn = rope[2 * (f1 + j) + 1];
                o1[j] = x1 * cs - x2 * sn; o2[j] = x2 * cs + x1 * sn; }
            u32x2 w; w.x = cvtpk(o1[0], o1[1]); w.y = cvtpk(o1[2], o1[3]); *(u32x2*)(dst + 64 + f1) = w;
            u32x2 w2; w2.x = cvtpk(o2[0], o2[1]); w2.y = cvtpk(o2[2], o2[3]); *(u32x2*)(dst + 80 + f1) = w2; }
    }
}

DI void norm_heads_inplace(const Ctx& C, bf16_t* z, int ld, int col0, int nheads, const float* __restrict__ gain) {
    const int sub = C.lane & 7; const long nchunks = (long)TOK * nheads;
    f32x4 g0 = *(const f32x4*)(gain + 8 * sub), g1 = *(const f32x4*)(gain + 8 * sub + 4);
    for (long c0 = (long)C.gw * 32 + (C.lane >> 3); c0 < nchunks; c0 += (long)C.NGW * 32) {
        u32x4 raw[4]; bf16_t* pp[4];
#pragma unroll
        for (int u = 0; u < 4; ++u) { const long c = c0 + 8 * u; const bool ok = c < nchunks; const long cc = ok ? c : 0;
            const int tok = (int)(cc / nheads), hd = (int)(cc % nheads);
            pp[u] = ok ? z + (size_t)tok * ld + col0 + hd * 64 + 8 * sub : nullptr;
            raw[u] = ok ? *(const u32x4*)pp[u] : (u32x4){0u, 0u, 0u, 0u}; }
#pragma unroll
        for (int u = 0; u < 4; ++u) {
            float v[8]; float ss = 0.f;
#pragma unroll
            for (int j = 0; j < 4; ++j) { v[2 * j] = bflo(raw[u][j]); v[2 * j + 1] = bfhi(raw[u][j]); ss += v[2 * j] * v[2 * j] + v[2 * j + 1] * v[2 * j + 1]; }
            ss += __shfl_xor(ss, 1); ss += __shfl_xor(ss, 2); ss += __shfl_xor(ss, 4);
            const float r = 1.0f / sqrtf(ss * (1.0f / 64.0f) + EPS);
            u32x4 w; w.x = cvtpk(v[0] * r * g0.x, v[1] * r * g0.y); w.y = cvtpk(v[2] * r * g0.z, v[3] * r * g0.w); w.z = cvtpk(v[4] * r * g1.x, v[5] * r * g1.y); w.w = cvtpk(v[6] * r * g1.z, v[7] * r * g1.w);
            if (pp[u]) *(u32x4*)pp[u] = w;
        }
    }
}
DI void vt_scatter(const Ctx& C, const bf16_t* z, int ld, int col0, int nheads, int hd_lo, int hd_n, int d, bf16_t* vT) {
    const long nitems = (long)(TOK / 64) * hd_n;
    for (long it = C.gw; it < nitems; it += C.NGW) {
        const int tile = (int)(it / hd_n), hd = hd_lo + (int)(it % hd_n);
        const int tok = tile * 64 + C.lane, b = tok >> 11, t = tok & 2047;
        const int pos = (t % d) * (SEQ / d) + t / d;
        const bf16_t* p = z + (size_t)tok * ld + col0 + hd * 64;
        bf16_t* o_ = vT + ((size_t)(b * nheads + hd) * 64) * SEQ + pos; asm volatile("" : "+v"(o_)); gbf16_t* o = (gbf16_t*)o_;
#pragma unroll
        for (int c8 = 0; c8 < 8; ++c8) { const u32x4 raw = *(const u32x4*)(p + 8 * c8);
#pragma unroll
            for (int j = 0; j < 4; ++j) { o[(size_t)(8 * c8 + 2 * j) * SEQ] = (bf16_t)(raw[j] & 0xffffu); o[(size_t)(8 * c8 + 2 * j + 1) * SEQ] = (bf16_t)(raw[j] >> 16); } }
    }
}

DI void phase_prep0(const Ctx& C, const KA& a) {
    unsigned char* ws = a.ws; bf16_t* z = (bf16_t*)(ws + WS_H);
    for (int it = C.gw; it < 4096; it += C.NGW) mla_prep_item(C, a, it);
    bf16_t* vdT = (bf16_t*)(ws + WS_VDT);
    vt_scatter(C, z, LD0, Z0_DIL + 1536, 12, 0, 4, 1, vdT);
    vt_scatter(C, z, LD0, Z0_DIL + 1536, 12, 4, 4, 4, vdT);
    vt_scatter(C, z, LD0, Z0_DIL + 1536, 12, 8, 4, 16, vdT);
    norm_heads_inplace(C, z, LD0, Z0_DIL + 768, 12, a.in(19));
}

DI const LAS float* load_t5_lds(const Ctx& C, const KA& a, int col0, int ncols) {
    __syncthreads();
    LAS float* t = (LAS float*)(C.lds + 4096); const float* src = (const float*)(a.ws + WS_T5) + col0 * TABW;
    const int n4 = ncols * TABW / 4;
    for (int i0 = C.tid; i0 < n4; i0 += 2048) {
        f32x4 v[4];
#pragma unroll
        for (int u = 0; u < 4; ++u) { const int i = i0 + 512 * u; v[u] = (i < n4) ? *(const f32x4*)(src + 4 * (size_t)i) : (f32x4){0.f, 0.f, 0.f, 0.f}; }
#pragma unroll
        for (int u = 0; u < 4; ++u) { const int i = i0 + 512 * u; if (i < n4) *(LAS f32x4*)(t + 4 * i) = v[u]; }
    }
    __syncthreads();
    return t + T5RB;
}
template <int DK, bool BIAS, bool SEL, int DSC = 1>
DI void attn_tiles_lds(f32x16& o0, f32x16& o1, float& m, float& l, const bf16x8 (&qf)[DK / 16], const char* kg, size_t kstride, const char* vg, size_t vstride,
                       int kt_lo, int kt_hi, int tq, int tq_min, int tq_max, int W, const LAS float* tab, unsigned selw, int blk_lo, int blk_hi,
                       LAS unsigned char* lds, int tile_off, int tid_in, int n, int h) {
    int tid = tid_in; asm volatile("" : "+v"(tid));
    constexpr int PK = DK * 2 + 16, PV = 136, KB = 64 * PK, BUF = KB + 64 * PV, PPR = DK / 8, NKP = 64 * PPR, NP = NKP + 512, NR = (NP + 511) / 512;
    LAS unsigned char* tbuf = lds + tile_off;
    constexpr bool PF2 = true;
    u32x4 r[NR], r2[PF2 ? NR : 1];
#define ATL_GLOAD(kt) do { _Pragma("unroll") for (int rr = 0; rr < NR; ++rr) { const int p = tid + 512 * rr; \
        if ((512 * (rr + 1) <= NKP) || ((512 * rr < NKP) && p < NKP)) r[rr] = *(const u32x4*)(kg + (size_t)(64 * (kt) + p / PPR) * kstride + (p % PPR) * 16); \
        else if ((512 * (rr + 1) <= NP) || p < NP) r[rr] = *(const u32x4*)(vg + (size_t)((p - NKP) >> 3) * vstride + (size_t)(64 * (kt)) * 2 + ((p - NKP) & 7) * 16); } } while (0)
#define ATL_LSTORE(buf) do { LAS unsigned char* bb_ = tbuf + (buf) * BUF; _Pragma("unroll") for (int rr = 0; rr < NR; ++rr) { const int p = tid + 512 * rr; \
        if ((512 * (rr + 1) <= NKP) || ((512 * rr < NKP) && p < NKP)) *(LAS u32x4*)(bb_ + (p / PPR) * PK + (p % PPR) * 16) = r[rr]; \
        else if ((512 * (rr + 1) <= NP) || p < NP) { LAS unsigned char* d_ = bb_ + KB + ((p - NKP) >> 3) * PV + ((p - NKP) & 7) * 16; *(LAS u32x2*)d_ = (u32x2){r[rr].x, r[rr].y}; *(LAS u32x2*)(d_ + 8) = (u32x2){r[rr].z, r[rr].w}; } } } while (0)
    __syncthreads();
    ATL_GLOAD(blk_lo); ATL_LSTORE(blk_lo & 1);
    if (PF2 && blk_lo < blk_hi) ATL_GLOAD(blk_lo + 1);
#pragma unroll 1
    for (int kt = blk_lo; kt <= blk_hi; ++kt) {
        __syncthreads();
        if (!PF2) { if (kt < blk_hi) ATL_GLOAD(kt + 1); }
        else if (kt + 2 <= blk_hi) { _Pragma("unroll") for (int rr = 0; rr < NR; ++rr) { const int p = tid + 512 * rr;
            if ((512 * (rr + 1) <= NKP) || ((512 * rr < NKP) && p < NKP)) r2[rr] = *(const u32x4*)(kg + (size_t)(64 * (kt + 2) + p / PPR) * kstride + (p % PPR) * 16);
            else if ((512 * (rr + 1) <= NP) || p < NP) r2[rr] = *(const u32x4*)(vg + (size_t)((p - NKP) >> 3) * vstride + (size_t)(64 * (kt + 2)) * 2 + ((p - NKP) & 7) * 16); } }
        bool work = (kt >= kt_lo && kt <= kt_hi);
        bool selok = true;
        if (SEL) { selok = ((selw >> kt) & 1u) != 0u; if (__builtin_amdgcn_ballot_w64(selok) == 0ull) work = false; }
        if (work) {
            const LAS unsigned char* bb = tbuf + (kt & 1) * BUF;
            const int k0 = 64 * kt;
            const int dbase = tq - k0 - 4 * h;
            const LAS float* tb = tab - dbase * DSC;
            f32x16 s0, s1;
            if (BIAS) {
#pragma unroll
                for (int i = 0; i < 16; ++i) { const int c = (i & 3) + 8 * (i >> 2); s0[i] = tb[c * DSC]; s1[i] = tb[(c + 32) * DSC]; }
            } else {
#pragma unroll
                for (int i = 0; i < 16; ++i) { s0[i] = 0.f; s1[i] = 0.f; }
            }
#pragma unroll
            for (int ks = 0; ks < DK / 16; ++ks) { const bf16x8 ka = *(const LAS bf16x8*)(bb + n * PK + (16 * ks + 8 * h) * 2), kb2 = *(const LAS bf16x8*)(bb + (32 + n) * PK + (16 * ks + 8 * h) * 2);
                s0 = MFMA32(ka, qf[ks], s0); s1 = MFMA32(kb2, qf[ks], s1); }
            const bool interior = (tq_min >= k0 + 63) && (tq_max - k0 < W) && (!SEL || __builtin_amdgcn_ballot_w64(!selok) == 0ull);
            if (!interior) {
#pragma unroll
                for (int i = 0; i < 16; ++i) { const int c = (i & 3) + 8 * (i >> 2);
                    s0[i] = ((unsigned)(dbase - c) < (unsigned)W && selok) ? s0[i] : -INFINITY;
                    s1[i] = ((unsigned)(dbase - c - 32) < (unsigned)W && selok) ? s1[i] : -INFINITY; }
            }
            float mxa = max3f(s0[0], s1[0], s0[1]), mxb = max3f(s1[1], s0[2], s1[2]);
#pragma unroll
            for (int i = 3; i < 15; i += 2) { mxa = max3f(mxa, s0[i], s1[i]); mxb = max3f(mxb, s0[i + 1], s1[i + 1]); }
            float mx = max3f(mxa, mxb, max2f(s0[15], s1[15]));
            mx = max2f(mx, __shfl_xor(mx, 32));
            if (__builtin_amdgcn_ballot_w64(mx - m > 8.0f) != 0ull) {
                const float mn = fmaxf(m, mx), mu_ = (mn == -INFINITY) ? 0.f : mn;
                const float alpha = fexp2(m - mu_); m = mn; l *= alpha;
#pragma unroll
                for (int i = 0; i < 16; ++i) { o0[i] *= alpha; o1[i] *= alpha; }
            }
            const float mu = (m == -INFINITY) ? 0.f : m;
            float rs = 0.f;
#pragma unroll
            for (int i = 0; i < 16; i += 2) {
                f32x2_t a2 = {s0[i], s0[i + 1]}, b2 = {s1[i], s1[i + 1]}; const f32x2_t nm = {-mu, -mu};
                a2 = a2 + nm; b2 = b2 + nm;
                s0[i] = fexp2(a2.x); s0[i + 1] = fexp2(a2.y); s1[i] = fexp2(b2.x); s1[i + 1] = fexp2(b2.y);
                rs += (s0[i] + s0[i + 1]) + (s1[i] + s1[i + 1]); }
            l += rs;
            bf16x8 pb[4];
            { u32x4 p; p.x = cvtpk(s0[0], s0[1]); p.y = cvtpk(s0[2], s0[3]); p.z = cvtpk(s0[4], s0[5]); p.w = cvtpk(s0[6], s0[7]); pb[0] = __builtin_bit_cast(bf16x8, p);
              p.x = cvtpk(s0[8], s0[9]); p.y = cvtpk(s0[10], s0[11]); p.z = cvtpk(s0[12], s0[13]); p.w = cvtpk(s0[14], s0[15]); pb[1] = __builtin_bit_cast(bf16x8, p);
              p.x = cvtpk(s1[0], s1[1]); p.y = cvtpk(s1[2], s1[3]); p.z = cvtpk(s1[4], s1[5]); p.w = cvtpk(s1[6], s1[7]); pb[2] = __builtin_bit_cast(bf16x8, p);
              p.x = cvtpk(s1[8], s1[9]); p.y = cvtpk(s1[10], s1[11]); p.z = cvtpk(s1[12], s1[13]); p.w = cvtpk(s1[14], s1[15]); pb[3] = __builtin_bit_cast(bf16x8, p); }
            const LAS unsigned char* vb = bb + KB + n * PV + 8 * h;
#pragma unroll
            for (int sx = 0; sx < 4; ++sx) {
                const s16x4 a0 = *(const LAS s16x4*)(vb + 32 * sx), a1 = *(const LAS s16x4*)(vb + 32 * sx + 16);
                const s16x4 b0 = *(const LAS s16x4*)(vb + 32 * PV + 32 * sx), b1 = *(const LAS s16x4*)(vb + 32 * PV + 32 * sx + 16);
                o0 = MFMA32(__builtin_shufflevector(a0, a1, 0, 1, 2, 3, 4, 5, 6, 7), pb[sx], o0);
                o1 = MFMA32(__builtin_shufflevector(b0, b1, 0, 1, 2, 3, 4, 5, 6, 7), pb[sx], o1);
            }
        }
        if (kt < blk_hi) ATL_LSTORE((kt + 1) & 1);
        if (PF2) {
#pragma unroll
            for (int rr = 0; rr < NR; ++rr) r[rr] = r2[rr];
        }
    }
#undef ATL_GLOAD
#undef ATL_LSTORE
}

DI void phase_att0(const Ctx& C, const KA& a) {
    unsigned char* ws = a.ws; const int n = C.n, h = C.h;
    bf16_t* z = (bf16_t*)(ws + WS_H);
    for (int prep_ = 0; prep_ < ((PROBE_SUB == 1) ? 2 : 1); ++prep_) {
        const bf16_t* qm = (const bf16_t*)(ws + WS_QM); const bf16_t* km = (const bf16_t*)(ws + WS_KM); const bf16_t* vmT = (const bf16_t*)(ws + WS_VMT);
        for (int it = 0;; ++it) {
            const int ge = deal(it, (int)blockIdx.x, C.G, 1024); if (ge < 0) { if ((long)it * C.G >= 1024) break; else continue; }
            const int qg = ge >> 7, bh = ge & 127, b = bh >> 3, head = bh & 7, qt = 8 * qg + C.wave;
            const int t = 32 * qt + n;
            bf16x8 qf[6];
            const bf16_t* qr = qm + ((size_t)bh * SEQ + t) * 96 + 8 * h;
#pragma unroll
            for (int ks = 0; ks < 6; ++ks) qf[ks] = *(const bf16x8*)(qr + 16 * ks);
            f32x16 o0, o1; zero16(o0); zero16(o1); float m = -INFINITY, l = 0.f;
            attn_tiles_lds<96, false, false>(o0, o1, m, l, qf, (const char*)(km + (size_t)bh * SEQ * 96), 192, (const char*)(vmT + (size_t)bh * 64 * SEQ), (size_t)SEQ * 2,
                                             0, qt >> 1, t, 32 * qt, 32 * qt + 31, 1 << 30, (const LAS float*)C.lds, 0u, 0, 4 * qg + 3, C.lds, 4096, C.tid, n, h);
            l += __shfl_xor(l, 32);
            store_o64(z + (size_t)(b * SEQ + t) * LD0 + Z0_MIX + head * 64, o0, o1, 1.0f / l, h);
        }
    }
    for (int prep_ = 0; prep_ < ((PROBE_SUB == 2) ? 2 : 1); ++prep_) {
        const LAS float* t5 = load_t5_lds(C, a, 0, 12);
        const bf16_t* vdT = (const bf16_t*)(ws + WS_VDT); bf16_t* og = (bf16_t*)(a.outb + OUT_OG); float* lse = (float*)(a.outb + OUT_LSE);
        const float* qg = a.in(18);
        for (int unit = (int)blockIdx.x; unit < 2048; unit += C.G) {
            int g, rem; if (unit < 512) { g = 0; rem = unit; } else if (unit < 1024) { g = 1; rem = unit - 512; } else { g = 2; rem = unit - 1024; }
            const int d = (g == 0) ? 1 : (g == 1 ? 4 : 16), Sd = SEQ / d;
            const int upbh = (g == 2) ? 16 : 8;
            const int bhh = rem / upbh, sub = rem % upbh, b = bhh >> 2, hgi = bhh & 3;
            const int spr = (g == 0) ? 8 : (g == 1 ? 2 : 1);
            const int r = sub / spr, pg = sub % spr;
            const int head12 = g * 4 + hgi, pt = 8 * pg + C.wave;
            const bool active = (32 * pt) < Sd;
            const int tp = active ? 32 * pt + n : n, tok = b * SEQ + tp * d + r;
            bf16x8 qf[4];
            load_q64(qf, z + (size_t)tok * LD0 + Z0_DIL + head12 * 64, qg, 0.125f * LOG2E, h);
            f32x16 o0, o1; zero16(o0); zero16(o1); float m = -INFINITY, l = 0.f;
            const int blo64 = (256 * pg - 128) > 0 ? ((256 * pg - 128) >> 6) : 0; const int bhi_ = 4 * pg + 3, bmax = Sd / 64 - 1; const int bhi64 = bhi_ < bmax ? bhi_ : bmax;
            int klo = (32 * pt - 128) > 0 ? ((32 * pt - 128) >> 6) : 0, khi = (32 * pt + 31) >> 6; if (!active) { klo = 1; khi = 0; }
            const char* kg = (const char*)(z + (size_t)(b * SEQ + r) * LD0 + Z0_DIL + 768 + head12 * 64);
            const char* vg = (const char*)(vdT + ((size_t)(b * 12 + head12) * 64) * SEQ + r * Sd);
            const LAS float* tab = t5 + head12 * TABW;
            if (g == 0) attn_tiles_lds<64, true, false, 1>(o0, o1, m, l, qf, kg, (size_t)LD0 * 2, vg, (size_t)SEQ * 2, klo, khi, tp, 32 * pt, 32 * pt + 31, 129, tab, 0u, blo64, bhi64, C.lds, 106496, C.tid, n, h);
            else if (g == 1) attn_tiles_lds<64, true, false, 4>(o0, o1, m, l, qf, kg, (size_t)LD0 * 8, vg, (size_t)SEQ * 2, klo, khi, tp, 32 * pt, 32 * pt + 31, 129, tab, 0u, blo64, bhi64, C.lds, 106496, C.tid, n, h);
            else attn_tiles_lds<64, true, false, 16>(o0, o1, m, l, qf, kg, (size_t)LD0 * 32, vg, (size_t)SEQ * 2, klo, khi, tp, 32 * pt, 32 * pt + 31, 129, tab, 0u, blo64, bhi64, C.lds, 106496, C.tid, n, h);
            if (active) {
                l += __shfl_xor(l, 32);
                store_o64(og + (((size_t)g * TOK + tok) * 4 + hgi) * 64, o0, o1, 1.0f / l, h);
                if (h == 0) lse[((size_t)g * TOK + tok) * 4 + hgi] = m + log2f(l);
            }
        }
    }
}

DI void phase_comb0(const Ctx& C, const KA& a) {
    unsigned char* ws = a.ws; bf16_t* z = (bf16_t*)(ws + WS_H);
    const bf16_t* og = (const bf16_t*)(a.outb + OUT_OG); const float* lse = (const float*)(a.outb + OUT_LSE);
    const long total = (long)TOK * 4 * 8;
    for (long i = (long)C.gw * 64 + C.lane; i < total; i += (long)C.NGW * 64) {
        const int c8 = (int)(i & 7); const long th = i >> 3; const int hg = (int)(th & 3); const int tok = (int)(th >> 2);
        const float l0 = lse[(size_t)tok * 4 + hg], l1 = lse[((size_t)TOK + tok) * 4 + hg], l2 = lse[((size_t)2 * TOK + tok) * 4 + hg];
        const float mx = fmaxf(l0, fmaxf(l1, l2));
        float w0 = fexp2(l0 - mx), w1 = fexp2(l1 - mx), w2 = fexp2(l2 - mx); const float inv = 1.0f / (w0 + w1 + w2); w0 *= inv; w1 *= inv; w2 *= inv;
        const u32x4 a0 = *(const u32x4*)(og + ((size_t)tok * 4 + hg) * 64 + 8 * c8), a1 = *(const u32x4*)(og + (((size_t)TOK + tok) * 4 + hg) * 64 + 8 * c8), a2 = *(const u32x4*)(og + (((size_t)2 * TOK + tok) * 4 + hg) * 64 + 8 * c8);
        u32x4 w;
#pragma unroll
        for (int j = 0; j < 4; ++j) w[j] = cvtpk(w0 * bflo(a0[j]) + w1 * bflo(a1[j]) + w2 * bflo(a2[j]), w0 * bfhi(a0[j]) + w1 * bfhi(a1[j]) + w2 * bfhi(a2[j]));
        *(u32x4*)(z + (size_t)tok * LD0 + Z0_MIX + 512 + hg * 64 + 8 * c8) = w;
    }
}

constexpr int Z1_SQ = 0, Z1_SK = 512, Z1_SV = 640, Z1_NQ = 768, Z1_KC = 1280, Z1_VC = 1408, Z1_KS = 1536, Z1_VS = 1664, Z1_KW = 1792, Z1_VW = 1920, Z1_G = 2048;

DI float gelu_tanh(float x) {
    const float u = 0.7978845608028654f * (x + 0.044715f * x * x * x);
    const float e = fexp2(-2.0f * LOG2E * fabsf(u)); const float th = (1.0f - e) * frcp(1.0f + e);
    return 0.5f * x * (1.0f + (u < 0.f ? -th : th));
}
DI void cmp_item(const Ctx& C, const KA& a, int item) {
    unsigned char* ws = a.ws; const int n = C.n, h = C.h;
    const int ct = item & 3, which = (item >> 2) & 1, g = (item >> 3) & 1, b = item >> 4;
    const bf16_t* z = (const bf16_t*)(ws + WS_H);
    int c = 32 * ct + n; const int cl = c < 127 ? c : 126;
    const bf16_t* zr = z + (size_t)(b * SEQ + 16 * cl) * LD1 + (which ? Z1_VC : Z1_KC) + g * 64 + 8 * h;
    const bf16_t* W1 = (const bf16_t*)(ws + WS_WC1) + (size_t)which * 128 * 2048; const bf16_t* W2 = (const bf16_t*)(ws + WS_WC2) + (size_t)which * 64 * 128;
    f32x16 hid[4];
#pragma unroll
    for (int ft = 0; ft < 4; ++ft) zero16(hid[ft]);
#pragma unroll 1
    for (int lq = 0; lq < 4; ++lq) {
        const int lt = 4 * C.wave + lq;
#pragma unroll
        for (int ks = 0; ks < 4; ++ks) {
            const bf16x8 bq = *(const bf16x8*)(zr + (size_t)lt * LD1 + 16 * ks);
#pragma unroll
            for (int ft = 0; ft < 4; ++ft) { const bf16x8 wa = *(const bf16x8*)(W1 + (size_t)(32 * ft + n) * 2048 + lt * 64 + 16 * ks + 8 * h); hid[ft] = MFMA32(wa, bq, hid[ft]); }
        }
    }
    LAS float* part = (LAS float*)C.lds;
    __syncthreads();
#pragma unroll
    for (int ft = 0; ft < 4; ++ft)
#pragma unroll
        for (int i = 0; i < 16; ++i) part[((C.wave * 4 + ft) * 16 + i) * 64 + C.lane] = hid[ft][i];
    __syncthreads();
    if (C.wave != 0) return;
#pragma unroll
    for (int ft = 0; ft < 4; ++ft)
#pragma unroll
        for (int i = 0; i < 16; ++i) { float t = 0.f;
#pragma unroll
            for (int w = 0; w < 8; ++w) t += part[((w * 4 + ft) * 16 + i) * 64 + C.lane];
            hid[ft][i] = t; }
    const float* cb = (const float*)(ws + WS_CB) + which * 128;
    f32x16 o0, o1; zero16(o0); zero16(o1);
#pragma unroll
    for (int ft = 0; ft < 4; ++ft) {
        float gv[16];
#pragma unroll
        for (int i = 0; i < 16; ++i) gv[i] = gelu_tanh(hid[ft][i] + cb[32 * ft + crow(i, h)]);
#pragma unroll
        for (int s = 0; s < 2; ++s) {
            u32x4 p; p.x = cvtpk(gv[8 * s], gv[8 * s + 1]); p.y = cvtpk(gv[8 * s + 2], gv[8 * s + 3]); p.z = cvtpk(gv[8 * s + 4], gv[8 * s + 5]); p.w = cvtpk(gv[8 * s + 6], gv[8 * s + 7]);
            const bf16x8 pb = __builtin_bit_cast(bf16x8, p);
            const bf16_t* w2 = W2 + (size_t)n * 128 + 32 * ft + 16 * s + 4 * h;
            const s16x4 a0 = *(const s16x4*)(w2), a1 = *(const s16x4*)(w2 + 8);
            const s16x4 b0 = *(const s16x4*)(w2 + 32 * 128), b1 = *(const s16x4*)(w2 + 32 * 128 + 8);
            o0 = MFMA32(__builtin_shufflevector(a0, a1, 0, 1, 2, 3, 4, 5, 6, 7), pb, o0);
            o1 = MFMA32(__builtin_shufflevector(b0, b1, 0, 1, 2, 3, 4, 5, 6, 7), pb, o1);
        }
    }
    if (which == 0) {
        float ss = 0.f;
#pragma unroll
        for (int i = 0; i < 16; ++i) ss += o0[i] * o0[i] + o1[i] * o1[i];
        ss += __shfl_xor(ss, 32);
        const float r = 1.0f / sqrtf(ss * (1.0f / 64.0f) + EPS);
        const float* kg = a.in(26);
        bf16_t* dst = (bf16_t*)(ws + WS_KC) + ((size_t)(b * 2 + g) * 128 + c) * 64;
#pragma unroll
        for (int q = 0; q < 4; ++q) { const int f = 8 * q + 4 * h; const f32x4 g0 = *(const f32x4*)(kg + f), g1 = *(const f32x4*)(kg + 32 + f);
            u32x2 w; w.x = cvtpk(o0[4 * q] * r * g0.x, o0[4 * q + 1] * r * g0.y); w.y = cvtpk(o0[4 * q + 2] * r * g0.z, o0[4 * q + 3] * r * g0.w); *(u32x2*)(dst + f) = w;
            u32x2 w2; w2.x = cvtpk(o1[4 * q] * r * g1.x, o1[4 * q + 1] * r * g1.y); w2.y = cvtpk(o1[4 * q + 2] * r * g1.z, o1[4 * q + 3] * r * g1.w); *(u32x2*)(dst + 32 + f) = w2; }
    } else {
        bf16_t* dst_ = (bf16_t*)(ws + WS_VCT) + ((size_t)(b * 2 + g) * 64 + 4 * h) * 128 + c; asm volatile("" : "+v"(dst_)); gbf16_t* dst = (gbf16_t*)dst_;
#pragma unroll
        for (int i = 0; i < 16; ++i) { dst[(size_t)crow(i, 0) * 128] = (bf16_t)(cvtpk(o0[i], 0.f) & 0xffffu); dst[(size_t)(32 + crow(i, 0)) * 128] = (bf16_t)(cvtpk(o1[i], 0.f) & 0xffffu); }
    }
}

DI void phase_prep1(const Ctx& C, const KA& a) {
    unsigned char* ws = a.ws; bf16_t* z = (bf16_t*)(ws + WS_H);
    for (int it = (int)blockIdx.x; it < 256; it += C.G) cmp_item(C, a, it);
    bf16_t* vt = (bf16_t*)(ws + WS_VT1); const size_t VTS = (size_t)BATCH * 2 * 64 * SEQ;
    vt_scatter(C, z, LD1, Z1_SV, 2, 0, 2, 1, vt);
    vt_scatter(C, z, LD1, Z1_VS, 2, 0, 2, 1, vt + VTS);
    vt_scatter(C, z, LD1, Z1_VW, 2, 0, 2, 1, vt + 2 * VTS);
    norm_heads_inplace(C, z, LD1, Z1_SK, 2, a.in(23));
    norm_heads_inplace(C, z, LD1, Z1_KS, 2, a.in(26) + 64);
    norm_heads_inplace(C, z, LD1, Z1_KW, 2, a.in(26) + 128);
}

DI float quad_sum(float v) {
    v += __builtin_bit_cast(float, __builtin_amdgcn_update_dpp(0, __builtin_bit_cast(int, v), 0xB1, 0xf, 0xf, true));
    v += __builtin_bit_cast(float, __builtin_amdgcn_update_dpp(0, __builtin_bit_cast(int, v), 0x4E, 0xf, 0xf, true));
    return v; }

DI void phase_att1(const Ctx& C, const KA& a) {
    unsigned char* ws = a.ws; const int n = C.n, h = C.h, r = n & 3, tl = n >> 2;
    const LAS float* t5 = load_t5_lds(C, a, 8, 8);
    const bf16_t* z = (const bf16_t*)(ws + WS_H); bf16_t* mixed = (bf16_t*)(ws + WS_MIX1);
    const bf16_t* vt = (const bf16_t*)(ws + WS_VT1); const size_t VTS = (size_t)BATCH * 2 * 64 * SEQ;
    const float qsc = 0.125f * LOG2E;
    for (int prep_ = 0; prep_ < ((PROBE_SUB == 3) ? 2 : 1); ++prep_)
    for (int it = 0;; ++it) {
        const int ge = deal(it, (int)blockIdx.x, C.G, 1024); if (ge < 0) { if ((long)it * C.G >= 1024) break; else continue; }
        const int tg = ge >> 5, bg = ge & 31, b = bg >> 1, g = bg & 1, head = g * 4 + r, tt = 8 * tg + C.wave;
        const int t = 8 * tt + tl, tok = b * SEQ + t;
        bf16x8 qf[4];
        load_q64(qf, z + (size_t)tok * LD1 + Z1_NQ + head * 64, a.in(25), qsc, h);
        const bf16_t* gz = z + (size_t)tok * LD1 + Z1_G + head * 3;
        const float g_cmp = frcp(1.0f + fexp2(-LOG2E * bf2f(gz[0]))), g_slc = frcp(1.0f + fexp2(-LOG2E * bf2f(gz[1]))), g_win = frcp(1.0f + fexp2(-LOG2E * bf2f(gz[2])));
        f32x16 r0, r1;
        unsigned selw;
        {
            constexpr int CKP = 144, CVP = 264, CVOFF = 128 * CKP;
            LAS unsigned char* cbuf = C.lds + 73728;
            __syncthreads();
            {
                const unsigned char* kcg = (const unsigned char*)((const bf16_t*)(ws + WS_KC) + (size_t)bg * 128 * 64);
                const unsigned char* vcg = (const unsigned char*)((const bf16_t*)(ws + WS_VCT) + (size_t)bg * 64 * 128);
#pragma unroll
                for (int rr = 0; rr < 2; ++rr) { const int p = C.tid + 512 * rr;
                    const u32x4 kv = *(const u32x4*)(kcg + (size_t)p * 16); *(LAS u32x4*)(cbuf + (p >> 3) * CKP + (p & 7) * 16) = kv;
                    const u32x4 vv = *(const u32x4*)(vcg + (size_t)p * 16); LAS unsigned char* dv = cbuf + CVOFF + (p >> 4) * CVP + (p & 15) * 16;
                    *(LAS u32x2*)dv = (u32x2){vv.x, vv.y}; *(LAS u32x2*)(dv + 8) = (u32x2){vv.z, vv.w}; }
            }
            __syncthreads();
            const LAS unsigned char* kc = cbuf + n * CKP + 16 * h;
            const LAS unsigned char* vc = cbuf + CVOFF + n * CVP + 8 * h;
            const int cmax = (t >= 31) ? ((t - 31) >> 4) : -1;
            float mx = -INFINITY;
#pragma unroll
            for (int kt = 0; kt < 4; ++kt) { f32x16 s; zero16(s); int lim = cmax - 4 * h; asm volatile("" : "+v"(lim));
#pragma unroll
                for (int ks = 0; ks < 4; ++ks) { const bf16x8 ka = *(const LAS bf16x8*)(kc + kt * 32 * CKP + 32 * ks); s = MFMA32(ka, qf[ks], s); }
#pragma unroll
                for (int i = 0; i < 16; ++i) { const int c = 32 * kt + crow(i, 0); mx = fmaxf(mx, (c <= lim) ? s[i] : -INFINITY); }
                asm volatile("" ::: "memory"); }
            mx = fmaxf(mx, __shfl_xor(mx, 32));
            const float mu = (mx == -INFINITY) ? 0.f : mx; float sum = 0.f;
#pragma unroll
            for (int kt = 0; kt < 4; ++kt) { f32x16 s; zero16(s); int lim = cmax - 4 * h; asm volatile("" : "+v"(lim));
#pragma unroll
                for (int ks = 0; ks < 4; ++ks) { const bf16x8 ka = *(const LAS bf16x8*)(kc + kt * 32 * CKP + 32 * ks); s = MFMA32(ka, qf[ks], s); }
#pragma unroll
                for (int i = 0; i < 16; ++i) { const int c = 32 * kt + crow(i, 0); sum += (c <= lim) ? fexp2(s[i] - mu) : 0.f; }
                asm volatile("" ::: "memory"); }
            sum += __shfl_xor(sum, 32);
            const float inv = 1.0f / fmaxf(sum, 1e-30f);
            float own[16], lastv[16];
            f32x16 o0, o1; zero16(o0); zero16(o1);
#pragma unroll
            for (int kt = 0; kt < 4; ++kt) { f32x16 s; zero16(s); int lim = cmax - 4 * h; asm volatile("" : "+v"(lim));
#pragma unroll
                for (int ks = 0; ks < 4; ++ks) { const bf16x8 ka = *(const LAS bf16x8*)(kc + kt * 32 * CKP + 32 * ks); s = MFMA32(ka, qf[ks], s); }
#pragma unroll
                for (int i = 0; i < 16; ++i) { const int c = 32 * kt + crow(i, 0); s[i] = (c <= lim) ? fexp2(s[i] - mu) * inv : 0.f; }
#pragma unroll
                for (int q = 0; q < 4; ++q) { const float p3 = quad_sum(s[4 * q + 3]); const float p012 = quad_sum(s[4 * q] + s[4 * q + 1] + s[4 * q + 2]); own[4 * kt + q] = p012 + p3; lastv[4 * kt + q] = p3; }
#pragma unroll
                for (int sx = 0; sx < 2; ++sx) {
                    u32x4 p; p.x = cvtpk(s[8 * sx], s[8 * sx + 1]); p.y = cvtpk(s[8 * sx + 2], s[8 * sx + 3]); p.z = cvtpk(s[8 * sx + 4], s[8 * sx + 5]); p.w = cvtpk(s[8 * sx + 6], s[8 * sx + 7]);
                    const bf16x8 pb = __builtin_bit_cast(bf16x8, p);
                    const LAS unsigned char* vp = vc + 64 * kt + 32 * sx;
                    const s16x4 a0 = *(const LAS s16x4*)(vp), a1 = *(const LAS s16x4*)(vp + 16), b0 = *(const LAS s16x4*)(vp + 32 * CVP), b1 = *(const LAS s16x4*)(vp + 32 * CVP + 16);
                    o0 = MFMA32(__builtin_shufflevector(a0, a1, 0, 1, 2, 3, 4, 5, 6, 7), pb, o0);
                    o1 = MFMA32(__builtin_shufflevector(b0, b1, 0, 1, 2, 3, 4, 5, 6, 7), pb, o1);
                }
                asm volatile("" ::: "memory"); }
#pragma unroll
            for (int i = 0; i < 16; ++i) { r0[i] = g_cmp * o0[i]; r1[i] = g_cmp * o1[i]; }
            float imp[32];
#pragma unroll
            for (int idx = 0; idx < 16; ++idx) {
                const float rl = __shfl_xor(lastv[idx], 32);
                const float rlm = (idx > 0) ? __shfl_xor(lastv[idx > 0 ? idx - 1 : 0], 32) : 0.f;
                const float mine = own[idx] + (h ? rl : rlm);
                const float theirs = __shfl_xor(mine, 32);
                imp[2 * idx] = h ? theirs : mine; imp[2 * idx + 1] = h ? mine : theirs;
            }
            const int tb = tt >> 3;
            if (tb <= 15) selw = (2u << tb) - 1u;
            else {
                unsigned sel = 1u | (1u << tb) | (1u << (tb - 1));
#pragma unroll
                for (int j2 = 0; j2 < 32; ++j2) imp[j2] = (j2 >= 1 && j2 <= tb - 2) ? imp[j2] : -1.0f;
#pragma unroll 1
                for (int j = 1; j <= tb - 2; ++j) {
                    float ij = 0.f;
#pragma unroll
                    for (int j2 = 1; j2 < 30; ++j2) ij = (j2 == j) ? imp[j2] : ij;
                    int rank = 0;
#pragma unroll
                    for (int j2 = 1; j2 < 30; ++j2) rank += ((j2 < j) ? (imp[j2] >= ij) : (imp[j2] > ij)) ? 1 : 0;
                    if (rank < 13) sel |= (1u << j);
                }
                selw = sel;
            }
        }
        {
            f32x16 o0, o1; zero16(o0); zero16(o1); float m = -INFINITY, l = 0.f;
            attn_tiles_lds<64, true, true>(o0, o1, m, l, qf, (const char*)(z + (size_t)(b * SEQ) * LD1 + Z1_KS + g * 64), (size_t)LD1 * 2, (const char*)(vt + VTS + (size_t)bg * 64 * SEQ), (size_t)SEQ * 2,
                                           0, tg, t, 8 * tt, 8 * tt + 7, 1 << 30, t5 + head * TABW, selw, 0, tg, C.lds, 73728, C.tid, n, h);
            l += __shfl_xor(l, 32); const float sc = g_slc / l;
#pragma unroll
            for (int i = 0; i < 16; ++i) { r0[i] += sc * o0[i]; r1[i] += sc * o1[i]; }
        }
        {
            f32x16 o0, o1; zero16(o0); zero16(o1); float m = -INFINITY, l = 0.f;
            const int wlo = tg > 8 ? tg - 8 : 0;
            attn_tiles_lds<64, true, false>(o0, o1, m, l, qf, (const char*)(z + (size_t)(b * SEQ) * LD1 + Z1_KW + g * 64), (size_t)LD1 * 2, (const char*)(vt + 2 * VTS + (size_t)bg * 64 * SEQ), (size_t)SEQ * 2,
                                            wlo, tg, t, 8 * tt, 8 * tt + 7, 512, t5 + head * TABW, 0u, wlo, tg, C.lds, 73728, C.tid, n, h);
            l += __shfl_xor(l, 32); const float sc = g_win / l;
#pragma unroll
            for (int i = 0; i < 16; ++i) { r0[i] += sc * o0[i]; r1[i] += sc * o1[i]; }
        }
        { int tok2 = b * SEQ + t; asm volatile("" : "+v"(tok2));
          store_o64(mixed + (size_t)tok2 * DM + 512 + head * 64, r0, r1, 1.0f, h); }
    }
    for (int prep_ = 0; prep_ < ((PROBE_SUB == 4) ? 2 : 1); ++prep_) {
        t5 = load_t5_lds(C, a, 0, 8);
        const float* sinks = a.in(24);
        for (int gi = (int)blockIdx.x; gi < 1024; gi += C.G) {
            const int tg = gi >> 5, bg = gi & 31, b = bg >> 1, g = bg & 1, head = g * 4 + r, tt = 8 * tg + C.wave;
            const int t = 8 * tt + tl, tok = b * SEQ + t;
            bf16x8 qf[4];
            load_q64(qf, z + (size_t)tok * LD1 + Z1_SQ + head * 64, a.in(22), qsc, h);
            f32x16 o0, o1; zero16(o0); zero16(o1); float m = -INFINITY, l = 0.f;
            const int wlo = tg > 2 ? tg - 2 : 0;
            attn_tiles_lds<64, true, false>(o0, o1, m, l, qf, (const char*)(z + (size_t)(b * SEQ) * LD1 + Z1_SK + g * 64), (size_t)LD1 * 2, (const char*)(vt + (size_t)bg * 64 * SEQ), (size_t)SEQ * 2,
                                            wlo, tg, t, 8 * tt, 8 * tt + 7, 128, t5 + head * TABW, 0u, wlo, tg, C.lds, 73728, C.tid, n, h);
            l += __shfl_xor(l, 32);
            const float sk = sinks[head] * LOG2E; const float mf = fmaxf(m, sk);
            const float den = l * fexp2(m - mf) + fexp2(sk - mf);
            store_o64(mixed + (size_t)tok * DM + head * 64, o0, o1, fexp2(m - mf) / den, h);
        }
    }
}


constexpr size_t WS_CTL = WS_SMALL + 6 * MiB;
constexpr int LDS_BAR_OFF = 147456 - 64;
#define XB_TMO      128
#define XB_XCNT(j)  (256  + 64 * (j))
#define XB_XSUB(j)  (1280 + 64 * (j))
#define XB_XGEN(j)  (2304 + 64 * (j))
#define XB_TOP      3328
#define XB_TOPGEN   3392
#define XCD_BAR_WORDS 3456
#define XB_SPIN_CAP (1u << 26)
DI unsigned xb_ld(unsigned* p)              { return __hip_atomic_load(p, __ATOMIC_RELAXED, __HIP_MEMORY_SCOPE_AGENT); }
DI unsigned xb_add(unsigned* p, unsigned v) { return __hip_atomic_fetch_add(p, v, __ATOMIC_RELAXED, __HIP_MEMORY_SCOPE_AGENT); }
DI unsigned xb_xcc_id() { return (unsigned)__builtin_amdgcn_s_getreg((3 << 11) | 20) & 0xFu; }
#define XB_SPIN(cond, bar) do { unsigned _sp = 0; while (cond) { __builtin_amdgcn_s_sleep(1); \
    if ((++_sp & 255u) == 0u) { if (xb_ld(&(bar)[XB_TMO])) break; if (_sp > XB_SPIN_CAP) { atomicAdd(&(bar)[XB_TMO], 1u); break; } } } } while (0)
struct XcdBarrier { unsigned* bar; unsigned x; volatile LAS unsigned* st; };
DI XcdBarrier xcd_barrier_post(unsigned* bar, volatile LAS unsigned* st) {
    XcdBarrier b; b.bar = bar; b.x = xb_xcc_id(); b.st = st;
    if (threadIdx.x == 0) (void)xb_add(&bar[XB_XCNT(b.x)], 1u);
    return b;
}
DI void xcd_barrier_complete(unsigned* bar, unsigned x, unsigned& nloc, unsigned& nx) {
    const unsigned G = gridDim.x * gridDim.y * gridDim.z;
    unsigned sum, cnt, mine, sp = 0u;
    for (;;) {
        sum = 0u; cnt = 0u; mine = 0u;
#pragma unroll
        for (unsigned j = 0; j < 16; ++j) { const unsigned c = xb_ld(&bar[XB_XCNT(j)]); sum += c; cnt += (c > 0u) ? 1u : 0u; mine = (j == x) ? c : mine; }
        if (sum == G) break;
        __builtin_amdgcn_s_sleep(1);
        if ((++sp & 255u) == 0u) { if (xb_ld(&bar[XB_TMO])) break; if (sp > XB_SPIN_CAP) { atomicAdd(&bar[XB_TMO], 1u); break; } }
    }
    nloc = mine > 0u ? mine : 1u; nx = cnt > 0u ? cnt : 1u;
}
DI void xcd_barrier(const XcdBarrier& b) {
    asm volatile("s_waitcnt vmcnt(0)" ::: "memory");
    __syncthreads();
    if (threadIdx.x == 0) {
        unsigned* bar = b.bar;
        __builtin_amdgcn_s_waitcnt(0);
        unsigned nloc = b.st[0], nx = b.st[1];
        if (nloc == 0u) { xcd_barrier_complete(bar, b.x, nloc, nx); b.st[0] = nloc; b.st[1] = nx; }
        const unsigned old = xb_add(&bar[XB_XSUB(b.x)], 1u);
        const unsigned gen = old / nloc;
        if (old + 1u == (gen + 1u) * nloc) {
            __builtin_amdgcn_fence(__ATOMIC_RELEASE, "agent");
            asm volatile("s_waitcnt vmcnt(0)" ::: "memory");
            const unsigned og = xb_add(&bar[XB_TOP], 1u);
            const unsigned tg = og / nx;
            if (og + 1u == (tg + 1u) * nx) xb_add(&bar[XB_TOPGEN], 1u);
            else XB_SPIN(xb_ld(&bar[XB_TOPGEN]) == tg, bar);
            __builtin_amdgcn_fence(__ATOMIC_ACQUIRE, "agent");
            xb_add(&bar[XB_XGEN(b.x)], 1u);
            asm volatile("s_waitcnt vmcnt(0)" ::: "memory");
        } else {
            XB_SPIN(xb_ld(&bar[XB_XGEN(b.x)]) == gen, bar);
            __builtin_amdgcn_fence(__ATOMIC_ACQUIRE, "agent");
            asm volatile("s_waitcnt vmcnt(0)" ::: "memory");
        }
    }
    __syncthreads();
}

constexpr int NPHASE = 18;
#ifndef PROBE_PH
#define PROBE_PH (-1)
#endif
#define PHON(k) (((MASK) >> (k)) & 1)
constexpr int LDS_BYTES = 147456;

template <int MASK> __global__ void __launch_bounds__(512, 2) mega_fwd(Args a) {
    extern __shared__ __attribute__((aligned(16))) unsigned char lds_raw[];
    cg::grid_group grid = cg::this_grid();
    if (a.ph_hi - a.ph_lo > 1) {
        volatile LAS unsigned* st = (volatile LAS unsigned*)((LAS unsigned char*)lds_raw + LDS_BAR_OFF);
        if (threadIdx.x < 2) st[threadIdx.x] = 0u;
        __syncthreads();
        (void)xcd_barrier_post((unsigned*)(a.ws + WS_CTL), st);
        grid.sync();
    }
    for (int ph = a.ph_lo; ph < a.ph_hi; ++ph) {
#define MKCTX() Ctx C; { int tid_ = threadIdx.x; asm volatile("" : "+v"(tid_)); C.lds = (LAS unsigned char*)lds_raw; C.tid = tid_; C.lane = C.tid & 63; C.wave = __builtin_amdgcn_readfirstlane(C.tid >> 6); \
        C.n = C.lane & 31; C.h = C.lane >> 5; { int G_ = gridDim.x; asm volatile("" : "+s"(G_)); C.G = G_; } C.gw = blockIdx.x * 8 + C.wave; C.NGW = C.G * 8; }
        KA ka; ka.k = (kptr_t)__builtin_amdgcn_kernarg_segment_ptr(); asm volatile("" : "+s"(ka.k));
        ka.ws = *(unsigned char* const __attribute__((address_space(4)))*)(ka.k + 256); float* outp = *(float* const __attribute__((address_space(4)))*)(ka.k + 248);
        ka.outb = (unsigned char*)outp;
        unsigned char* ws = ka.ws;
        float* rss = (float*)(ws + WS_RSS); bf16_t* xb = (bf16_t*)(ws + WS_XB); bf16_t* Hb = (bf16_t*)(ws + WS_H);
        for (int rep = 0; rep < ((ph == PROBE_PH) ? 2 : 1); ++rep) {
        int kind, arg = 0;
        switch (ph) {
            case 0: kind = 0; break;
            case 1: kind = 1; arg = 0; break;    case 2: kind = 2; arg = 0; break;
            case 3: kind = 3; arg = 0; break;    case 4: kind = 4; break;   case 5: kind = 5; break;   case 6: kind = 6; break;
            case 7: kind = 2; arg = 4; break;
            case 8: kind = 1; arg = 1; break;    case 9: kind = 2; arg = 1; break;
            case 10: kind = 1; arg = 2; break;   case 11: kind = 2; arg = 2; break;
            case 12: kind = 3; arg = 1; break;   case 13: kind = 7; break;  case 14: kind = 8; break;
            case 15: kind = 2; arg = 5; break;
            case 16: kind = 1; arg = 3; break;   default: kind = 2; arg = 3; break;
        }
        if (kind == 0) { if (PHON(0)) { MKCTX(); phase_prologue(C, ka); } }
        else if (kind == 1) { if (PHON(1)) { MKCTX();
                        pg8::Gemm g{xb, (const bf16_t*)(ws + WS_WGU) + (size_t)arg * 5632 * 1024, TOK, 5632, DM, DM};
            pg8::StaticOrder S; S.init(TOK, 5632, C.G, (int)blockIdx.x);
            pg8::EpiSwiglu E{rss, Hb};
            pg8::gemm_phase<pg8::EpiSwiglu>(C.lds, C.tid, g, S, E); }
        } else if (kind == 2) { if (PHON(2)) { MKCTX();
            pg8::Gemm g; pg8::EpiResid E;
            E.out = nullptr; E.base = nullptr; E.baseb = xb; E.xb = xb; E.alpha = 0.5f;
            if (arg < 4) { g = pg8::Gemm{Hb, (const bf16_t*)(ws + WS_WDN) + (size_t)arg * 1024 * FF, TOK, DM, FF, FF};
                if (arg == 0) { E.base = ka.in(0); E.baseb = nullptr; }
                E.rss = (arg == 0) ? rss : (arg == 1 ? rss : (arg == 2 ? rss : nullptr));
                if (arg == 3) { E.xb = nullptr; E.out = outp; }
            } else if (arg == 4) { g = pg8::Gemm{Hb + Z0_MIX, (const bf16_t*)(ws + WS_WOUT0), TOK, DM, 768, LD0}; E.alpha = 1.0f; E.rss = rss; }
            else { g = pg8::Gemm{(const bf16_t*)(ws + WS_MIX1), (const bf16_t*)(ws + WS_WOUT1), TOK, DM, DM, DM}; E.alpha = 1.0f; E.rss = rss; }
            pg8::StaticOrder S; S.init(TOK, DM, C.G, (int)blockIdx.x);
            pg8::gemm_phase<pg8::EpiResid>(C.lds, C.tid, g, S, E); }
        } else if (kind == 3) { if (PHON(3)) { MKCTX();
            pg8::Gemm g; pg8::EpiScale E; pg8::StaticOrder S;
            if (arg == 0) { g = pg8::Gemm{xb, (const bf16_t*)(ws + WS_WIN0), TOK, LD0, DM, DM}; E = pg8::EpiScale{rss, Hb, LD0}; S.init(TOK, LD0, C.G, (int)blockIdx.x); }
            else { g = pg8::Gemm{xb, (const bf16_t*)(ws + WS_WIN1), TOK, LD1, DM, DM}; E = pg8::EpiScale{rss, Hb, LD1}; S.init(TOK, LD1, C.G, (int)blockIdx.x); }
            pg8::gemm_phase<pg8::EpiScale>(C.lds, C.tid, g, S, E); }
        } else if (kind == 4) { if (PHON(4)) { MKCTX(); phase_prep0(C, ka); } }
        else if (kind == 5) { if (PHON(5)) { MKCTX(); phase_att0(C, ka); } }
        else if (kind == 6) { if (PHON(6)) { MKCTX(); phase_comb0(C, ka); } }
        else if (kind == 7) { if (PHON(7)) { MKCTX(); phase_prep1(C, ka); } }
        else { if (PHON(8)) { MKCTX(); phase_att1(C, ka); } }
        }
        if (ph + 1 < a.ph_hi) { XcdBarrier xbar; xbar.bar = (unsigned*)(ws + WS_CTL); xbar.x = xb_xcc_id(); xbar.st = (volatile LAS unsigned*)((LAS unsigned char*)lds_raw + LDS_BAR_OFF); xcd_barrier(xbar); }
    }
}

#ifndef MULTI_LAUNCH
#define MULTI_LAUNCH 0
#endif

extern "C" void kernel_launch(void* const* d_in, const int* in_sizes, int n_in, void* d_out, int out_size, void* d_ws, size_t ws_size, hipStream_t stream) {
    static int grid = 0;
    if (grid == 0) {
        if (n_in != 31 || out_size != TOK * DM || ws_size < WS_END) { fprintf(stderr, "kernel_launch: unexpected shapes n_in %d out %d ws %zu\n", n_in, out_size, ws_size); grid = -1; return; }
        int dev = 0, cus = 0, per_cu = 0;
        (void)hipGetDevice(&dev); (void)hipDeviceGetAttribute(&cus, hipDeviceAttributeMultiprocessorCount, dev);
#if MULTI_LAUNCH
        const void* fns[9] = {(const void*)mega_fwd<1>, (const void*)mega_fwd<2>, (const void*)mega_fwd<4>, (const void*)mega_fwd<8>, (const void*)mega_fwd<16>, (const void*)mega_fwd<32>, (const void*)mega_fwd<64>, (const void*)mega_fwd<128>, (const void*)mega_fwd<256>};
        for (int i = 0; i < 9; ++i) if (hipFuncSetAttribute(fns[i], hipFuncAttributeMaxDynamicSharedMemorySize, LDS_BYTES) != hipSuccess) { fprintf(stderr, "kernel_launch: hipFuncSetAttribute failed\n"); grid = -1; return; }
        per_cu = 1;
#else
        if (hipFuncSetAttribute((const void*)mega_fwd<0x1ff>, hipFuncAttributeMaxDynamicSharedMemorySize, LDS_BYTES) != hipSuccess) { fprintf(stderr, "kernel_launch: hipFuncSetAttribute failed\n"); grid = -1; return; }
        if (hipOccupancyMaxActiveBlocksPerMultiprocessor(&per_cu, (const void*)mega_fwd<0x1ff>, 512, LDS_BYTES) != hipSuccess || per_cu < 1) { fprintf(stderr, "kernel_launch: occupancy query says %d\n", per_cu); per_cu = 1; }
#endif
        (void)hipGetLastError();
        grid = cus * 1;
    }
    if (grid < 0) return;
    Args a{};
    for (int i = 0; i < 31; ++i) a.in[i] = (const float*)d_in[i];
    a.out = (float*)d_out; a.ws = (unsigned char*)d_ws;
#if MULTI_LAUNCH
    static const int kinds[NPHASE] = {0, 1, 2, 3, 4, 5, 6, 2, 1, 2, 1, 2, 3, 7, 8, 2, 1, 2};
    for (int ph = 0; ph < NPHASE; ++ph) { a.ph_lo = ph; a.ph_hi = ph + 1;
        switch (kinds[ph]) {
            case 0: hipLaunchKernelGGL(mega_fwd<1>, dim3(grid), dim3(512), LDS_BYTES, stream, a); break;
            case 1: hipLaunchKernelGGL(mega_fwd<2>, dim3(grid), dim3(512), LDS_BYTES, stream, a); break;
            case 2: hipLaunchKernelGGL(mega_fwd<4>, dim3(grid), dim3(512), LDS_BYTES, stream, a); break;
            case 3: hipLaunchKernelGGL(mega_fwd<8>, dim3(grid), dim3(512), LDS_BYTES, stream, a); break;
            case 4: hipLaunchKernelGGL(mega_fwd<16>, dim3(grid), dim3(512), LDS_BYTES, stream, a); break;
            case 5: hipLaunchKernelGGL(mega_fwd<32>, dim3(grid), dim3(512), LDS_BYTES, stream, a); break;
            case 6: hipLaunchKernelGGL(mega_fwd<64>, dim3(grid), dim3(512), LDS_BYTES, stream, a); break;
            case 7: hipLaunchKernelGGL(mega_fwd<128>, dim3(grid), dim3(512), LDS_BYTES, stream, a); break;
            default: hipLaunchKernelGGL(mega_fwd<256>, dim3(grid), dim3(512), LDS_BYTES, stream, a); break;
        }
    }
#else
    a.ph_lo = 0; a.ph_hi = NPHASE;
    (void)hipMemsetAsync((char*)d_ws + WS_CTL, 0, 16384, stream);
    void* args[] = {&a};
    hipError_t e = hipLaunchCooperativeKernel((const void*)mega_fwd<0x1ff>, dim3(grid), dim3(512), args, LDS_BYTES, stream);
    if (e != hipSuccess) fprintf(stderr, "cooperative launch failed: %s (grid %d)\n", hipGetErrorString(e), grid);
#endif
}
```

```cpp
#include <hip/hip_runtime.h>
#include <hip/hip_cooperative_groups.h>
#include <cstdio>
#include <cstdint>
namespace cg = cooperative_groups;
#ifndef PROBE_SUB
#define PROBE_SUB 0
#endif

#define LAS __attribute__((address_space(3)))
#define DI __device__ __forceinline__
typedef unsigned short bf16_t;
typedef __attribute__((address_space(1))) unsigned short gbf16_t;
typedef short bf16x8 __attribute__((ext_vector_type(8)));
typedef short s16x4 __attribute__((ext_vector_type(4)));
typedef float f32x4 __attribute__((ext_vector_type(4)));
typedef float f32x16 __attribute__((ext_vector_type(16)));
typedef unsigned u32x4 __attribute__((ext_vector_type(4)));
typedef unsigned u32x2 __attribute__((ext_vector_type(2)));
typedef float f32x2_t __attribute__((ext_vector_type(2)));
typedef __bf16 bf16x2_t __attribute__((ext_vector_type(2)));

constexpr int BATCH = 16, SEQ = 2048, DM = 1024, FF = 2816, TOK = BATCH * SEQ;
constexpr int LD0 = 2816;
constexpr int LD1 = 2304;
constexpr int NIN0 = 2720, NIN1 = 2072;
constexpr int Z0_DIL = 416, Z0_MIX = 1952;
constexpr float EPS = 1e-6f, LOG2E = 1.4426950408889634f;
constexpr int T5RB = 2084;
constexpr int TABW = 2120;

constexpr size_t MiB = 1u << 20;
constexpr size_t WS_WGU = 0;
constexpr size_t WS_WDN = 44 * MiB;
constexpr size_t WS_WIN0 = 66 * MiB;
constexpr size_t WS_WOUT0 = WS_WIN0 + 5632 * 1024;
constexpr size_t WS_WIN1 = 73 * MiB;
constexpr size_t WS_WOUT1 = WS_WIN1 + 4608 * 1024;
constexpr size_t WS_WQB = 80 * MiB;
constexpr size_t WS_WKVB = WS_WQB + 512 * 1024;
constexpr size_t WS_WC1 = 81 * MiB;
constexpr size_t WS_WC2 = 82 * MiB;
constexpr size_t WS_SMALL = 84 * MiB;
constexpr size_t WS_RSS = 508 * MiB;
constexpr size_t WS_T5 = WS_SMALL + 1 * MiB;
constexpr size_t WS_ROPE = WS_SMALL + 2 * MiB;
constexpr size_t WS_CB = WS_SMALL + 3 * MiB;
constexpr size_t WS_KC = WS_SMALL + 4 * MiB;
constexpr size_t WS_VCT = WS_SMALL + 5 * MiB;
constexpr size_t WS_XB = 92 * MiB;
constexpr size_t WS_H = 156 * MiB;
constexpr size_t WS_A = 332 * MiB;
constexpr size_t WS_KM = WS_A;
constexpr size_t WS_VMT = WS_A + 48 * MiB;
constexpr size_t WS_VDT = WS_A + 80 * MiB;
constexpr size_t WS_QM = WS_A + 128 * MiB;
constexpr size_t OUT_OG = 0;
constexpr size_t OUT_LSE = 48 * MiB;
constexpr size_t WS_VT1 = WS_A;
constexpr size_t WS_MIX1 = WS_A + 32 * MiB;
constexpr size_t WS_END = 512 * MiB;

struct Args { const float* in[31]; float* out; unsigned char* ws; int ph_lo, ph_hi; };
typedef const __attribute__((address_space(4))) unsigned char* kptr_t;
struct KA {
    kptr_t k; unsigned char* ws; unsigned char* outb;
    __device__ __forceinline__ const float* in(int i) const { return *(const float* const __attribute__((address_space(4)))*)(k + 8 * i); }
};

DI unsigned cvtpk(float lo, float hi) { f32x2_t v = {lo, hi}; bf16x2_t b = __builtin_convertvector(v, bf16x2_t); return __builtin_bit_cast(unsigned, b); }
DI float bf2f(unsigned short u) { return __uint_as_float(((unsigned)u) << 16); }
DI float bflo(unsigned u) { return __uint_as_float(u << 16); }
DI float bfhi(unsigned u) { return __uint_as_float(u & 0xffff0000u); }
DI float fexp2(float x) { return __builtin_amdgcn_exp2f(x); }
DI float frcp(float x) { return __builtin_amdgcn_rcpf(x); }
DI int crow(int i, int h) { return (i & 3) + 8 * (i >> 2) + 4 * h; }
DI float max3f(float a, float b, float c) { float r; asm("v_max3_f32 %0, %1, %2, %3" : "=v"(r) : "v"(a), "v"(b), "v"(c)); return r; }
DI float max2f(float a, float b) { float r; asm("v_max_f32_e32 %0, %1, %2" : "=v"(r) : "v"(a), "v"(b)); return r; }
#define MFMA32(a, b, c) __builtin_amdgcn_mfma_f32_32x32x16_bf16((a), (b), (c), 0, 0, 0)

namespace pg8 {
constexpr int BM = 256, BK = 64, HALF = 128, HTB = HALF * BK * 2, STAGE_BYTES = 8 * HTB, NXCD = 8, WGM = 8;
DI int lds_byte(int r, int c) { const int st = (r >> 4) * 2 + (c >> 5), rr = r & 15, cc = c & 31, ob = rr * 64 + cc * 2; return st * 1024 + (ob ^ (((ob >> 9) & 1) << 5)); }
DI void stage_rc(int b, int& R, int& C) { const int st = b / 1024, sb = b % 1024, swz = sb ^ (((sb >> 9) & 1) << 5); R = (st >> 1) * 16 + swz / 64; C = (st & 1) * 32 + (swz % 64) / 2; }
DI int perm32(int rho) { const int n = rho >> 4, i = rho & 15; return 8 * (i >> 2) + 4 * n + (i & 3); }
struct Unit { int pm, pn; };
struct Gemm { const bf16_t* A; const bf16_t* Bt; int M, N, K, lda; };
struct StaticOrder {
    int nM, nN, nwg, G, c;
    DI void init(int M, int N, int G_, int c_) { nM = M / BM; nN = N / BM; nwg = nM * nN; G = G_; c = c_; }
    DI bool next(int i, Unit& u) const {
        const long L = (long)i * G + c; if (L >= nwg) return false;
        int wgid = (int)L; { const int q = nwg / NXCD, r = nwg % NXCD, xcd = wgid % NXCD, off = wgid / NXCD; wgid = (xcd < r ? xcd * (q + 1) : r * (q + 1) + (xcd - r) * q) + off; }
        const int nig = WGM * nN, gid = wgid / nig, fm = gid * WGM, gsz = (nM - fm) < WGM ? (nM - fm) : WGM;
        u.pm = fm + ((wgid % nig) % gsz); u.pn = (wgid % nig) / gsz; return true;
    }
};

DI float rss_sum(const float* rss, int row) {
    const f32x4* p = (const f32x4*)(rss + (size_t)row * 16); const f32x4 a = p[0], b = p[1], c = p[2], d = p[3];
    return (((a.x + a.y) + (a.z + a.w)) + ((b.x + b.y) + (b.z + b.w))) + (((c.x + c.y) + (c.z + c.w)) + ((d.x + d.y) + (d.z + d.w))); }
DI void row_rstd8(const float* rss, int row0, int lane, int fq, float (&rs)[8]) {
    float v[2];
#pragma unroll
    for (int e = 0; e < 2; ++e) { const int p = 2 * fq + e; const int row = row0 + (p >> 2) * 128 + (p & 3) * 16; v[e] = 1.0f / sqrtf(rss_sum(rss, row) * (1.0f / DM) + EPS); }
    const int fr = lane & 15;
#pragma unroll
    for (int q = 0; q < 4; ++q) { rs[2 * q] = __shfl(v[0], fr + 16 * q); rs[2 * q + 1] = __shfl(v[1], fr + 16 * q); }
}
struct EpiSwiglu {
    const float* rss; bf16_t* H;
    DI void operator()(const f32x4 (&acc)[2][2][4][2], const Unit& u, int wr, int wc, int fr, int fq) const {
        const int row0 = u.pm * BM + wr * 64 + fr, col = u.pn * 128 + wc * 32 + 8 * fq;
        float rs8[8]; row_rstd8(rss, row0, fr + 16 * fq, fq, rs8);
#pragma unroll
        for (int ai = 0; ai < 2; ++ai)
#pragma unroll
            for (int m = 0; m < 4; ++m) {
                const int row = row0 + ai * HALF + m * 16;
                const float rstd = rs8[ai * 4 + m];
                float hv[8];
#pragma unroll
                for (int n = 0; n < 2; ++n)
#pragma unroll
                    for (int j = 0; j < 4; j += 2) {
                        const float g0 = acc[ai][0][m][n][j] * rstd, u0 = acc[ai][1][m][n][j] * rstd, g1 = acc[ai][0][m][n][j + 1] * rstd, u1 = acc[ai][1][m][n][j + 1] * rstd;
                        const float d0 = 1.0f + fexp2(fminf(-g0 * LOG2E, 60.0f)), d1 = 1.0f + fexp2(fminf(-g1 * LOG2E, 60.0f));
                        const float rp = frcp(d0 * d1);
                        hv[4 * n + j] = g0 * (d1 * rp) * u0; hv[4 * n + j + 1] = g1 * (d0 * rp) * u1;
                    }
                u32x4 w; w.x = cvtpk(hv[0], hv[1]); w.y = cvtpk(hv[2], hv[3]); w.z = cvtpk(hv[4], hv[5]); w.w = cvtpk(hv[6], hv[7]);
                *(u32x4*)(H + (size_t)row * FF + col) = w;
            }
    }
};
struct EpiResid {
    const float* base; const bf16_t* baseb; float* out; bf16_t* xb; float* rss; float alpha;
    DI void operator()(const f32x4 (&acc)[2][2][4][2], const Unit& u, int wr, int wc, int fr, int fq) const {
        const int row0 = u.pm * BM + wr * 64 + fr, col0 = u.pn * BM + wc * 32 + 8 * fq;
        if (baseb) {
            u32x4 bw[2][4][2];
#pragma unroll
            for (int ai = 0; ai < 2; ++ai)
#pragma unroll
                for (int m = 0; m < 4; ++m)
#pragma unroll
                    for (int bj = 0; bj < 2; ++bj) bw[ai][m][bj] = *(const u32x4*)(baseb + (size_t)(row0 + ai * HALF + m * 16) * DM + col0 + bj * HALF);
#pragma unroll
            for (int ai = 0; ai < 2; ++ai)
#pragma unroll
                for (int m = 0; m < 4; ++m) {
                    const int row = row0 + ai * HALF + m * 16; float ss = 0.f;
#pragma unroll
                    for (int bj = 0; bj < 2; ++bj) {
                        const size_t off = (size_t)row * DM + col0 + bj * HALF; const u32x4 w = bw[ai][m][bj];
                        const f32x4 b0 = (f32x4){bflo(w.x), bfhi(w.x), bflo(w.y), bfhi(w.y)}, b1 = (f32x4){bflo(w.z), bfhi(w.z), bflo(w.w), bfhi(w.w)};
                        const f32x4 x0 = b0 + alpha * acc[ai][bj][m][0], x1 = b1 + alpha * acc[ai][bj][m][1];
                        if (out) { *(f32x4*)(out + off) = x0; *(f32x4*)(out + off + 4) = x1; }
                        if (xb) { u32x4 o; o.x = cvtpk(x0[0], x0[1]); o.y = cvtpk(x0[2], x0[3]); o.z = cvtpk(x1[0], x1[1]); o.w = cvtpk(x1[2], x1[3]); *(u32x4*)(xb + off) = o; }
                        ss += (x0[0] * x0[0] + x0[1] * x0[1]) + (x0[2] * x0[2] + x0[3] * x0[3]) + (x1[0] * x1[0] + x1[1] * x1[1]) + (x1[2] * x1[2] + x1[3] * x1[3]);
                    }
                    if (rss) { ss += __shfl_xor(ss, 16); ss += __shfl_xor(ss, 32); if (fq == 0) rss[(size_t)row * 16 + u.pn * 4 + wc] = ss; }
                }
            return;
        }
#pragma unroll
        for (int ai = 0; ai < 2; ++ai)
#pragma unroll
            for (int m = 0; m < 4; ++m) {
                const int row = row0 + ai * HALF + m * 16; float ss = 0.f;
#pragma unroll
                for (int bj = 0; bj < 2; ++bj) {
                    const size_t off = (size_t)row * DM + col0 + bj * HALF;
                    const f32x4 b0 = *(const f32x4*)(base + off), b1 = *(const f32x4*)(base + off + 4);
                    const f32x4 x0 = b0 + alpha * acc[ai][bj][m][0], x1 = b1 + alpha * acc[ai][bj][m][1];
                    if (out) { *(f32x4*)(out + off) = x0; *(f32x4*)(out + off + 4) = x1; }
                    if (xb) { u32x4 w; w.x = cvtpk(x0[0], x0[1]); w.y = cvtpk(x0[2], x0[3]); w.z = cvtpk(x1[0], x1[1]); w.w = cvtpk(x1[2], x1[3]); *(u32x4*)(xb + off) = w; }
                    ss += (x0[0] * x0[0] + x0[1] * x0[1]) + (x0[2] * x0[2] + x0[3] * x0[3]) + (x1[0] * x1[0] + x1[1] * x1[1]) + (x1[2] * x1[2] + x1[3] * x1[3]);
                }
                if (rss) { ss += __shfl_xor(ss, 16); ss += __shfl_xor(ss, 32); if (fq == 0) rss[(size_t)row * 16 + u.pn * 4 + wc] = ss; }
                asm volatile("" ::: "memory");
            }
    }
};
struct EpiScale {
    const float* rss; bf16_t* Z; int ldz;
    DI void operator()(const f32x4 (&acc)[2][2][4][2], const Unit& u, int wr, int wc, int fr, int fq) const {
        const int row0 = u.pm * BM + wr * 64 + fr, col0 = u.pn * BM + wc * 32 + 8 * fq;
        float rs8[8]; row_rstd8(rss, row0, fr + 16 * fq, fq, rs8);
#pragma unroll
        for (int ai = 0; ai < 2; ++ai)
#pragma unroll
            for (int m = 0; m < 4; ++m) {
                const int row = row0 + ai * HALF + m * 16;
                const float rstd = rs8[ai * 4 + m];
#pragma unroll
                for (int bj = 0; bj < 2; ++bj) {
                    const f32x4 v0 = acc[ai][bj][m][0] * rstd, v1 = acc[ai][bj][m][1] * rstd;
                    u32x4 w; w.x = cvtpk(v0[0], v0[1]); w.y = cvtpk(v0[2], v0[3]); w.z = cvtpk(v1[0], v1[1]); w.w = cvtpk(v1[2], v1[3]);
                    *(u32x4*)(Z + (size_t)row * ldz + col0 + bj * HALF) = w;
                }
            }
    }
};

template <class Epi>
DI void gemm_phase(LAS unsigned char* lds, const int tid, const Gemm g, const StaticOrder& S, const Epi& E) {
    const int wid = __builtin_amdgcn_readfirstlane(tid >> 6), lane = tid & 63, wr = wid >> 2, wc = wid & 3, fr = lane & 15, fq = lane >> 4;
    const int K = g.K, nt = K / BK, lda = g.lda;
    unsigned voffA[2], voffB[2];
#pragma unroll
    for (int i = 0; i < 2; ++i) { int R, C; stage_rc(tid * 16 + i * 8192, R, C); const int Rb = (R & ~31) + perm32(R & 31);
        voffA[i] = (unsigned)(R * lda + C) * 2u; voffB[i] = (unsigned)(Rb * K + C) * 2u; }
    const size_t kstep = (size_t)(BK * 2);
    const size_t hstepA = (size_t)HALF * lda * 2, hstepB = (size_t)HALF * K * 2;
    const size_t tstepA = 2 * hstepA, tstepB = 2 * hstepB;
    const unsigned ldsw = (unsigned)wid * 1024u;
    const int aoff = lds_byte(wr * 64 + fr, fq * 8), boff = lds_byte(wc * 32 + fr, fq * 8);
#define PG8_SA(b, h) (((b) * 2 + (h)) * HTB)
#define PG8_SB(b, h) ((4 + (b) * 2 + (h)) * HTB)
#define PG8_STAGE(bufoff, gbase, voff) do { _Pragma("unroll") for (int _i = 0; _i < 2; ++_i) \
        __builtin_amdgcn_global_load_lds((const unsigned*)((const char*)(gbase) + (voff)[_i]), (LAS unsigned*)(lds + (bufoff) + ldsw + _i * 8192), 16, 0, 0); } while (0)
#define PG8_LDA(dst, b, h) do { _Pragma("unroll") for (int m = 0; m < 4; ++m) _Pragma("unroll") for (int k = 0; k < 2; ++k) dst[m][k] = *(const LAS bf16x8*)(lds + PG8_SA(b, h) + aoff + m * 2048 + k * 1024); } while (0)
#define PG8_LDB(dst, b, h) do { _Pragma("unroll") for (int n = 0; n < 2; ++n) _Pragma("unroll") for (int k = 0; k < 2; ++k) dst[n][k] = *(const LAS bf16x8*)(lds + PG8_SB(b, h) + boff + n * 2048 + k * 1024); } while (0)
#define PG8_MMA(ai, bj, At, Bt) do { __builtin_amdgcn_s_setprio(1); _Pragma("unroll") for (int m = 0; m < 4; ++m) _Pragma("unroll") for (int n = 0; n < 2; ++n) _Pragma("unroll") for (int k = 0; k < 2; ++k) \
        acc[ai][bj][m][n] = __builtin_amdgcn_mfma_f32_16x16x32_bf16(Bt[n][k], At[m][k], acc[ai][bj][m][n], 0, 0, 0); __builtin_amdgcn_s_setprio(0); } while (0)
#define PG8_WAIT_V(n) asm volatile("s_waitcnt vmcnt(" #n ")" ::: "memory")
#define PG8_WAIT_L(n) asm volatile("s_waitcnt lgkmcnt(" #n ")" ::: "memory")
#define PG8_BAR __builtin_amdgcn_s_barrier()
#define PG8_SCHED __builtin_amdgcn_sched_barrier(0)
    Unit cur, nxt; int ui = 0;
    if (!S.next(0, cur)) return;
    f32x4 acc[2][2][4][2];
#pragma unroll
    for (int a = 0; a < 2; ++a)
#pragma unroll
        for (int b = 0; b < 2; ++b)
#pragma unroll
            for (int m = 0; m < 4; ++m)
#pragma unroll
                for (int n = 0; n < 2; ++n) acc[a][b][m][n] = (f32x4){0.f, 0.f, 0.f, 0.f};
    bf16x8 At[4][2], B0[2][2], B1[2][2];
    const char* cA = (const char*)g.A + (size_t)cur.pm * tstepA; const char* cB = (const char*)g.Bt + (size_t)cur.pn * tstepB;
    PG8_STAGE(PG8_SB(0, 0), cB, voffB); PG8_STAGE(PG8_SB(0, 1), cB + hstepB, voffB); PG8_STAGE(PG8_SA(0, 0), cA, voffA); PG8_STAGE(PG8_SA(0, 1), cA + hstepA, voffA);
    if (wr == 1) PG8_BAR;
    PG8_WAIT_V(2); PG8_BAR;
    PG8_STAGE(PG8_SB(1, 0), cB + kstep, voffB); PG8_STAGE(PG8_SA(1, 0), cA + kstep, voffA); PG8_STAGE(PG8_SB(1, 1), cB + hstepB + kstep, voffB);
    PG8_WAIT_V(6); PG8_BAR;
    for (;;) {
        const bool has_next = S.next(ui + 1, nxt);
        const char* nA = has_next ? (const char*)g.A + (size_t)nxt.pm * tstepA : cA; const char* nB = has_next ? (const char*)g.Bt + (size_t)nxt.pn * tstepB : cB;
        for (int t = 0; t < nt; t += 2) {
            const bool last = (t == nt - 2);
            const char* a1 = cA + (size_t)(t + 1) * kstep;
            const char* a2 = last ? nA : cA + (size_t)(t + 2) * kstep; const char* b2 = last ? nB : cB + (size_t)(t + 2) * kstep;
            const char* a3 = a2 + kstep; const char* b3 = b2 + kstep;
            PG8_LDB(B0, 0, 0); PG8_LDB(B1, 0, 1); PG8_SCHED; PG8_LDA(At, 0, 0); PG8_STAGE(PG8_SA(1, 1), a1 + hstepA, voffA);
            PG8_WAIT_V(8); PG8_WAIT_L(0); PG8_BAR; PG8_MMA(0, 0, At, B0); PG8_MMA(0, 1, At, B1); PG8_BAR; PG8_SCHED;
            PG8_LDA(At, 0, 1); PG8_STAGE(PG8_SB(0, 0), b2, voffB); PG8_STAGE(PG8_SB(0, 1), b2 + hstepB, voffB); PG8_STAGE(PG8_SA(0, 0), a2, voffA);
            PG8_WAIT_V(8); PG8_WAIT_L(0); PG8_BAR; PG8_MMA(1, 0, At, B0); PG8_MMA(1, 1, At, B1); PG8_BAR; PG8_SCHED;
            PG8_LDB(B0, 1, 0); PG8_LDB(B1, 1, 1); PG8_SCHED; PG8_LDA(At, 1, 0); PG8_STAGE(PG8_SA(0, 1), a2 + hstepA, voffA);
            PG8_WAIT_V(8); PG8_WAIT_L(0); PG8_BAR; PG8_MMA(0, 0, At, B0); PG8_MMA(0, 1, At, B1); PG8_BAR; PG8_SCHED;
            PG8_LDA(At, 1, 1); PG8_STAGE(PG8_SB(1, 0), b3, voffB); PG8_STAGE(PG8_SB(1, 1), b3 + hstepB, voffB); PG8_STAGE(PG8_SA(1, 0), a3, voffA);
            PG8_WAIT_V(8); PG8_WAIT_L(0); PG8_BAR; PG8_MMA(1, 0, At, B0); PG8_MMA(1, 1, At, B1); PG8_BAR; PG8_SCHED;
        }
        if (wr == 0) PG8_BAR;
        E(acc, cur, wr, wc, fr, fq);
        if (!has_next) break;
#pragma unroll
        for (int a = 0; a < 2; ++a)
#pragma unroll
            for (int b = 0; b < 2; ++b)
#pragma unroll
                for (int m = 0; m < 4; ++m)
#pragma unroll
                    for (int n = 0; n < 2; ++n) acc[a][b][m][n] = (f32x4){0.f, 0.f, 0.f, 0.f};
        cur = nxt; cA = nA; cB = nB; ++ui;
        if (wr == 1) PG8_BAR;
    }
    PG8_WAIT_V(0);
    PG8_BAR;
#undef PG8_SA
#undef PG8_SB
#undef PG8_STAGE
#undef PG8_LDA
#undef PG8_LDB
#undef PG8_MMA
}
}

struct Ctx {
    LAS unsigned char* lds;
    int tid, lane, wave, n, h;
    int gw, NGW, G;
};

DI int t5_bucket(int n) {
    if (n < 16) return n;
    const int v = 16 + (int)(__builtin_amdgcn_logf((float)n * 0.0625f) * (16.0f / 7.0f));
    return v < 31 ? v : 31;
}

DI void transpose_item(const float* __restrict__ W, int K, int N, bf16_t* WT, int ldw, int row_base, const float* __restrict__ gain, LAS float* scr, int item, int lane) {
    const int nblk = (N + 63) / 64, kb = item / nblk, nb = item % nblk, k0 = 64 * kb, n0 = 64 * nb, nn = n0 + lane;
    float tv[64];
#pragma unroll
    for (int i = 0; i < 64; ++i) tv[i] = (nn < N) ? W[(size_t)(k0 + i) * N + nn] : 0.f;
#pragma unroll
    for (int i = 0; i < 64; ++i) { float v = tv[i]; if (gain) v *= gain[k0 + i]; scr[i * 65 + lane] = v; }
    asm volatile("s_waitcnt lgkmcnt(0)" ::: "memory");
    const int c = lane & 7;
#pragma unroll
    for (int j = 0; j < 8; ++j) { const int nl = (lane >> 3) + 8 * j; const LAS float* s = scr + (8 * c) * 65 + nl;
        u32x4 o; o.x = cvtpk(s[0 * 65], s[1 * 65]); o.y = cvtpk(s[2 * 65], s[3 * 65]); o.z = cvtpk(s[4 * 65], s[5 * 65]); o.w = cvtpk(s[6 * 65], s[7 * 65]);
        *(u32x4*)(WT + (size_t)(row_base + nl) * ldw + k0 + 8 * c) = o; }
    asm volatile("s_waitcnt lgkmcnt(0)" ::: "memory");
}

DI void phase_prologue(const Ctx& C, const KA& a) {
    unsigned char* ws = a.ws;
    LAS float* scr = (LAS float*)(C.lds + C.wave * 16640);
    const int I_GU = 16 * 44, I_DN = 44 * 16, I_IN0 = 16 * 43, I_OUT0 = 12 * 16, I_IN1 = 16 * 33, I_OUT1 = 16 * 16, I_QB = 4 * 12, I_KVB = 2 * 16, I_C1 = 32 * 2, I_C2 = 2 * 1;
    const int NIT = 8 * I_GU + 4 * I_DN + I_IN0 + I_OUT0 + I_IN1 + I_OUT1 + I_QB + I_KVB + 2 * I_C1 + 2 * I_C2;
    for (int prep_ = 0; prep_ < ((PROBE_SUB == 6) ? 2 : 1); ++prep_)
    for (int it = C.gw; it < NIT; it += C.NGW) {
        int r = it;
        if (r < 8 * I_GU) {
            const int mat = r / I_GU, item = r % I_GU, l = mat >> 2, f = (mat >> 1) & 1, up = mat & 1;
            const float* W = a.in(f ? (up ? 9 : 8) : (up ? 4 : 3)) + (size_t)l * DM * FF;
            const float* gn = a.in(f ? 7 : 2) + l * DM;
            const int nb = item % 44, n0 = 64 * nb;
            bf16_t* WT = (bf16_t*)(ws + WS_WGU) + (size_t)(l * 2 + f) * 5632 * 1024;
            transpose_item(W, DM, FF, WT, DM, (n0 >> 7) * 256 + up * 128 + (n0 & 127), gn, scr, item, C.lane);
            continue;
        }
        r -= 8 * I_GU;
        if (r < 4 * I_DN) { const int mat = r / I_DN, item = r % I_DN, l = mat >> 1, f = mat & 1;
            const float* W = a.in(f ? 10 : 5) + (size_t)l * FF * DM;
            bf16_t* WT = (bf16_t*)(ws + WS_WDN) + (size_t)(l * 2 + f) * 1024 * FF;
            transpose_item(W, FF, DM, WT, FF, 64 * (item % 16), nullptr, scr, item, C.lane); continue; }
        r -= 4 * I_DN;
        if (r < I_IN0) { transpose_item(a.in(11), DM, NIN0, (bf16_t*)(ws + WS_WIN0), DM, 64 * (r % 43), a.in(6), scr, r, C.lane); continue; }
        r -= I_IN0;
        if (r < I_OUT0) { transpose_item(a.in(20), 768, DM, (bf16_t*)(ws + WS_WOUT0), 768, 64 * (r % 16), nullptr, scr, r, C.lane); continue; }
        r -= I_OUT0;
        if (r < I_IN1) { transpose_item(a.in(21), DM, NIN1, (bf16_t*)(ws + WS_WIN1), DM, 64 * (r % 33), a.in(6) + DM, scr, r, C.lane); continue; }
        r -= I_IN1;
        if (r < I_OUT1) { transpose_item(a.in(30), DM, DM, (bf16_t*)(ws + WS_WOUT1), DM, 64 * (r % 16), nullptr, scr, r, C.lane); continue; }
        r -= I_OUT1;
        if (r < I_QB) { transpose_item(a.in(13), 256, 768, (bf16_t*)(ws + WS_WQB), 256, 64 * (r % 12), a.in(12), scr, r, C.lane); continue; }
        r -= I_QB;
        if (r < I_KVB) { transpose_item(a.in(15), 128, 1024, (bf16_t*)(ws + WS_WKVB), 128, 64 * (r % 16), a.in(14), scr, r, C.lane); continue; }
        r -= I_KVB;
        if (r < 2 * I_C1) { const int w = r / I_C1, item = r % I_C1;
            transpose_item(a.in(28) + (size_t)w * 2048 * 128, 2048, 128, (bf16_t*)(ws + WS_WC1) + (size_t)w * 128 * 2048, 2048, 64 * (item % 2), nullptr, scr, item, C.lane); continue; }
        r -= 2 * I_C1;
        { const int w = r / I_C2, item = r % I_C2;
            transpose_item(a.in(29) + (size_t)w * 128 * 64, 128, 64, (bf16_t*)(ws + WS_WC2) + (size_t)w * 64 * 128, 128, 0, nullptr, scr, item, C.lane); }
    }
    {
        const float* x = a.in(0); bf16_t* xb = (bf16_t*)(ws + WS_XB); float* rss = (float*)(ws + WS_RSS);
        for (int prep_ = 0; prep_ < ((PROBE_SUB == 7) ? 2 : 1); ++prep_)
        for (int m0 = 2 * C.gw; m0 < TOK; m0 += 2 * C.NGW) {
            f32x4 v[2][4];
#pragma unroll
            for (int rr = 0; rr < 2; ++rr) { const f32x4* xr = (const f32x4*)(x + (size_t)(m0 + rr) * DM) + C.lane;
#pragma unroll
                for (int j = 0; j < 4; ++j) v[rr][j] = xr[64 * j]; }
#pragma unroll
            for (int rr = 0; rr < 2; ++rr) { const int m = m0 + rr; float s = 0.f;
                unsigned long long* o8 = (unsigned long long*)(xb + (size_t)m * DM) + C.lane;
#pragma unroll
                for (int j = 0; j < 4; ++j) { const f32x4 w = v[rr][j]; s += (w.x * w.x + w.y * w.y) + (w.z * w.z + w.w * w.w);
                    o8[64 * j] = (unsigned long long)cvtpk(w.x, w.y) | ((unsigned long long)cvtpk(w.z, w.w) << 32); }
#pragma unroll
                for (int o = 1; o < 64; o <<= 1) s += __shfl_xor(s, o);
                if (C.lane < 16) rss[(size_t)m * 16 + C.lane] = (C.lane == 0) ? s : 0.f; }
        }
        const int gt = C.gw * 64 + C.lane, NT = C.NGW * 64;
        float* t5 = (float*)(ws + WS_T5); const float* rb = a.in(1);
        for (int i = gt; i < 16 * TABW; i += NT) { const int col = i / TABW, d = T5RB - i % TABW; float v = 0.f; if (d >= 0 && d <= 2048) v = rb[t5_bucket(d) * 16 + col] * LOG2E; t5[i] = v; }
        float* rope = (float*)(ws + WS_ROPE);
        for (int i = gt; i < 2048 * 16; i += NT) { const int t = i >> 4, f = i & 15; const float inv = fexp2(-(float)f * (13.287712379549449f / 16.0f)); const float ang = (float)t * inv;
            const double rev = (double)ang * 0.15915494309189535; const float fr = (float)(rev - __builtin_rint(rev));
            rope[2 * i] = __builtin_amdgcn_cosf(fr); rope[2 * i + 1] = __builtin_amdgcn_sinf(fr); }
        float* cb = (float*)(ws + WS_CB);
        for (int o = C.gw; o < 256; o += C.NGW) { const int w = o >> 7, j = o & 127; const float* pos = a.in(27) + w * 2048; const float* w1 = a.in(28) + (size_t)w * 2048 * 128; float sacc = 0.f;
#pragma unroll 8
            for (int k = C.lane; k < 2048; k += 64) sacc += pos[k] * w1[(size_t)k * 128 + j];
#pragma unroll
            for (int off = 1; off < 64; off <<= 1) sacc += __shfl_xor(sacc, off);
            if (C.lane == 0) cb[o] = sacc; }
    }
}

template <int DK, int DSC, bool BIAS, bool SEL, bool LOCK = false>
DI void attn_tiles(f32x16& o0, f32x16& o1, float& m, float& l, const bf16x8 (&qf)[DK / 16], const char* kl, size_t kstride, const char* vl, size_t vstride,
                   int kt_lo, int kt_hi, int tq, int W, const LAS float* tab, unsigned selw, int h, int blk_lo = 0, int blk_hi = 0) {
    if (LOCK) { for (int kt = blk_lo; kt < kt_lo; ++kt) __builtin_amdgcn_s_barrier(); }
    bf16x8 kf[DK / 16]; s16x4 va[8];
    {
        const char* kp = kl + (size_t)(32 * kt_lo) * kstride;
#pragma unroll
        for (int ks = 0; ks < DK / 16; ++ks) kf[ks] = *(const bf16x8*)(kp + ks * 32);
        const char* vp = vl + (size_t)(32 * kt_lo) * 2; const char* vp2 = vp + 32 * vstride;
#pragma unroll
        for (int j = 0; j < 4; ++j) { va[j] = *(const s16x4*)(vp + 16 * j); va[4 + j] = *(const s16x4*)(vp2 + 16 * j); }
    }
#pragma unroll 1
    for (int kt = kt_lo; kt <= kt_hi; ++kt) {
        const int k0 = 32 * kt;
        if (LOCK) __builtin_amdgcn_s_barrier();
        f32x16 s;
#pragma unroll
        for (int i = 0; i < 16; ++i) s[i] = 0.f;
#pragma unroll
        for (int ks = 0; ks < DK / 16; ++ks) s = MFMA32(kf[ks], qf[ks], s);
        __builtin_amdgcn_sched_barrier(0);
        s16x4 vb[8];
        {
            const int ktn = (kt < kt_hi) ? kt + 1 : kt_hi;
            const char* kp = kl + (size_t)(32 * ktn) * kstride;
#pragma unroll
            for (int ks = 0; ks < DK / 16; ++ks) kf[ks] = *(const bf16x8*)(kp + ks * 32);
            const char* vp = vl + (size_t)(32 * ktn) * 2; const char* vp2 = vp + 32 * vstride;
#pragma unroll
            for (int j = 0; j < 4; ++j) { vb[j] = *(const s16x4*)(vp + 16 * j); vb[4 + j] = *(const s16x4*)(vp2 + 16 * j); }
        }
        asm volatile("" ::: "memory");
        __builtin_amdgcn_sched_barrier(0);
        const int dbase = tq - k0 - 4 * h;
        const bool selok = SEL ? (((selw >> (kt >> 1)) & 1u) != 0u) : true;
        const LAS float* tb = tab + (dbase - 27) * DSC;
        float mx = -INFINITY;
#pragma unroll
        for (int i = 0; i < 16; ++i) {
            const int c = (i & 3) + 8 * (i >> 2); const int delta = dbase - c;
            float v = s[i]; if (BIAS) v += tb[(27 - c) * DSC];
            v = ((unsigned)delta < (unsigned)W && selok) ? v : -INFINITY; s[i] = v; mx = fmaxf(mx, v);
        }
        mx = fmaxf(mx, __shfl_xor(mx, 32));
        const float mn = fmaxf(m, mx), mu = (mn == -INFINITY) ? 0.f : mn;
        const float alpha = fexp2(m - mu); m = mn;
        float rs = 0.f;
#pragma unroll
        for (int i = 0; i < 16; ++i) { s[i] = fexp2(s[i] - mu); rs += s[i]; }
        l = l * alpha + rs;
#pragma unroll
        for (int i = 0; i < 16; ++i) { o0[i] *= alpha; o1[i] *= alpha; }
        u32x4 p0, p1;
        p0.x = cvtpk(s[0], s[1]); p0.y = cvtpk(s[2], s[3]); p0.z = cvtpk(s[4], s[5]); p0.w = cvtpk(s[6], s[7]);
        p1.x = cvtpk(s[8], s[9]); p1.y = cvtpk(s[10], s[11]); p1.z = cvtpk(s[12], s[13]); p1.w = cvtpk(s[14], s[15]);
        const bf16x8 pb0 = __builtin_bit_cast(bf16x8, p0), pb1 = __builtin_bit_cast(bf16x8, p1);
        o0 = MFMA32(__builtin_shufflevector(va[0], va[1], 0, 1, 2, 3, 4, 5, 6, 7), pb0, o0);
        o0 = MFMA32(__builtin_shufflevector(va[2], va[3], 0, 1, 2, 3, 4, 5, 6, 7), pb1, o0);
        o1 = MFMA32(__builtin_shufflevector(va[4], va[5], 0, 1, 2, 3, 4, 5, 6, 7), pb0, o1);
        o1 = MFMA32(__builtin_shufflevector(va[6], va[7], 0, 1, 2, 3, 4, 5, 6, 7), pb1, o1);
        __builtin_amdgcn_sched_barrier(0);
#pragma unroll
        for (int j = 0; j < 8; ++j) va[j] = vb[j];
    }
    if (LOCK) { for (int kt = kt_hi + 1; kt <= blk_hi; ++kt) __builtin_amdgcn_s_barrier(); }
}

DI void load_q64(bf16x8 (&qf)[4], const bf16_t* qrow, const float* __restrict__ gain, float scale, int h) {
    u32x4 raw[4]; float ss = 0.f;
#pragma unroll
    for (int ks = 0; ks < 4; ++ks) { raw[ks] = *(const u32x4*)(qrow + 16 * ks + 8 * h);
#pragma unroll
        for (int j = 0; j < 4; ++j) { const float a = bflo(raw[ks][j]), b = bfhi(raw[ks][j]); ss += a * a + b * b; } }
    ss += __shfl_xor(ss, 32);
    const float r = scale / sqrtf(ss * (1.0f / 64.0f) + EPS);
#pragma unroll
    for (int ks = 0; ks < 4; ++ks) { u32x4 w; const f32x4 g0 = *(const f32x4*)(gain + 16 * ks + 8 * h), g1 = *(const f32x4*)(gain + 16 * ks + 8 * h + 4);
        w.x = cvtpk(bflo(raw[ks].x) * r * g0.x, bfhi(raw[ks].x) * r * g0.y); w.y = cvtpk(bflo(raw[ks].y) * r * g0.z, bfhi(raw[ks].y) * r * g0.w);
        w.z = cvtpk(bflo(raw[ks].z) * r * g1.x, bfhi(raw[ks].z) * r * g1.y); w.w = cvtpk(bflo(raw[ks].w) * r * g1.z, bfhi(raw[ks].w) * r * g1.w);
        qf[ks] = __builtin_bit_cast(bf16x8, w); }
}

DI void zero16(f32x16& v) {
#pragma unroll
    for (int i = 0; i < 16; ++i) v[i] = 0.f;
}
DI void store_o64(bf16_t* dst, const f32x16& o0, const f32x16& o1, float sc, int h) {
#pragma unroll
    for (int q = 0; q < 4; ++q) {
        u32x2 w; w.x = cvtpk(o0[4 * q] * sc, o0[4 * q + 1] * sc); w.y = cvtpk(o0[4 * q + 2] * sc, o0[4 * q + 3] * sc);
        *(u32x2*)(dst + 8 * q + 4 * h) = w;
        u32x2 w2; w2.x = cvtpk(o1[4 * q] * sc, o1[4 * q + 1] * sc); w2.y = cvtpk(o1[4 * q + 2] * sc, o1[4 * q + 3] * sc);
        *(u32x2*)(dst + 32 + 8 * q + 4 * h) = w2;
    }
}

DI int deal(int it, int gw, int NGW, int total) {
    int pos = gw; if (it & 1) pos = NGW - 1 - gw;
    const long e = (long)it * NGW + pos; return e < total ? (int)e : -1;
}

DI void mla_prep_item(const Ctx& C, const KA& a, int item) {
    unsigned char* ws = a.ws;
    int ln_ = C.lane; asm volatile("" : "+v"(ln_));
    const int tt = item >> 2, part = item & 3, n = ln_ & 31, h = ln_ >> 5;
    const int tok = tt * 32 + n, b = tok >> 11, t = tok & 2047;
    const bf16_t* zr = (const bf16_t*)(ws + WS_H) + (size_t)tok * LD0;
    const bf16_t* Wqb = (const bf16_t*)(ws + WS_WQB); const bf16_t* Wkvb = (const bf16_t*)(ws + WS_WKVB);
    const float* rope = (const float*)(ws + WS_ROPE) + (size_t)t * 32;
    bf16x8 cq[16];
    {
        u32x4 raw[16]; float ss = 0.f;
#pragma unroll
        for (int ks = 0; ks < 16; ++ks) { raw[ks] = *(const u32x4*)(zr + 16 * ks + 8 * h);
#pragma unroll
            for (int j = 0; j < 4; ++j) { const float x = bflo(raw[ks][j]), y = bfhi(raw[ks][j]); ss += x * x + y * y; } }
        ss += __shfl_xor(ss, 32);
        const float r = 1.0f / sqrtf(ss * (1.0f / 256.0f) + EPS);
#pragma unroll
        for (int ks = 0; ks < 16; ++ks) { u32x4 w;
#pragma unroll
            for (int j = 0; j < 4; ++j) w[j] = cvtpk(bflo(raw[ks][j]) * r, bfhi(raw[ks][j]) * r);
            cq[ks] = __builtin_bit_cast(bf16x8, w); }
    }
    const float* qg = a.in(16); const float* kg = a.in(17);
    bf16_t* qm = (bf16_t*)(ws + WS_QM); bf16_t* km = (bf16_t*)(ws + WS_KM); bf16_t* vmT = (bf16_t*)(ws + WS_VMT);
    const float qscale = 0.10206207261596575f * LOG2E;
#pragma unroll 1
    for (int hh = 0; hh < 2; ++hh) {
        const int head = part * 2 + hh;
        f32x16 acc3[3];
#pragma unroll
        for (int ft = 0; ft < 3; ++ft) { zero16(acc3[ft]); const bf16_t* wr = Wqb + (size_t)(head * 96 + 32 * ft + n) * 256 + 8 * h;
#pragma unroll
            for (int k8 = 0; k8 < 16; k8 += 8) { bf16x8 wa[8];
#pragma unroll
                for (int j = 0; j < 8; ++j) wa[j] = *(const bf16x8*)(wr + 16 * (k8 + j));
#pragma unroll
                for (int j = 0; j < 8; ++j) acc3[ft] = MFMA32(wa[j], cq[k8 + j], acc3[ft]);
                asm volatile("" ::: "memory"); } }
        float ss = 0.f;
#pragma unroll
        for (int ft = 0; ft < 3; ++ft)
#pragma unroll
            for (int i = 0; i < 16; ++i) ss += acc3[ft][i] * acc3[ft][i];
        ss += __shfl_xor(ss, 32);
        const float r = qscale / sqrtf(ss * (1.0f / 96.0f) + EPS);
        bf16_t* dst = qm + ((size_t)(b * 8 + head) * SEQ + t) * 96;
#pragma unroll
        for (int ft = 0; ft < 2; ++ft)
#pragma unroll
            for (int q = 0; q < 4; ++q) { const int f = 32 * ft + 8 * q + 4 * h; const f32x4 g = *(const f32x4*)(qg + f);
                u32x2 w; w.x = cvtpk(acc3[ft][4 * q] * r * g.x, acc3[ft][4 * q + 1] * r * g.y); w.y = cvtpk(acc3[ft][4 * q + 2] * r * g.z, acc3[ft][4 * q + 3] * r * g.w);
                *(u32x2*)(dst + f) = w; }
#pragma unroll
        for (int q = 0; q < 2; ++q) { const int f1 = 8 * q + 4 * h; const f32x4 g1 = *(const f32x4*)(qg + 64 + f1), g2 = *(const f32x4*)(qg + 80 + f1);
            float o1[4], o2[4];
#pragma unroll
            for (int j = 0; j < 4; ++j) { const float x1 = acc3[2][4 * q + j] * r * g1[j], x2 = acc3[2][4 * q + 8 + j] * r * g2[j]; const float cs = rope[2 * (f1 + j)], sn = rope[2 * (f1 + j) + 1];
                o1[j] = x1 * cs - x2 * sn; o2[j] = x2 * cs + x1 * sn; }
            u32x2 w; w.x = cvtpk(o1[0], o1[1]); w.y = cvtpk(o1[2], o1[3]); *(u32x2*)(dst + 64 + f1) = w;
            u32x2 w2; w2.x = cvtpk(o2[0], o2[1]); w2.y = cvtpk(o2[2], o2[3]); *(u32x2*)(dst + 80 + f1) = w2; }
    }
    asm volatile("" ::: "memory");
    bf16x8 ckv[8];
    {
        u32x4 raw[8]; float ss = 0.f;
#pragma unroll
        for (int ks = 0; ks < 8; ++ks) { raw[ks] = *(const u32x4*)(zr + 256 + 16 * ks + 8 * h);
#pragma unroll
            for (int j = 0; j < 4; ++j) { const float x = bflo(raw[ks][j]), y = bfhi(raw[ks][j]); ss += x * x + y * y; } }
        ss += __shfl_xor(ss, 32);
        const float r = 1.0f / sqrtf(ss * (1.0f / 128.0f) + EPS);
#pragma unroll
        for (int ks = 0; ks < 8; ++ks) { u32x4 w;
#pragma unroll
            for (int j = 0; j < 4; ++j) w[j] = cvtpk(bflo(raw[ks][j]) * r, bfhi(raw[ks][j]) * r);
            ckv[ks] = __builtin_bit_cast(bf16x8, w); }
    }
    float kr1[8], kr2[8]; float ssr = 0.f;
#pragma unroll
    for (int q = 0; q < 2; ++q) { const u32x2 r1 = *(const u32x2*)(zr + 384 + 8 * q + 4 * h), r2 = *(const u32x2*)(zr + 400 + 8 * q + 4 * h);
        kr1[4 * q] = bflo(r1.x); kr1[4 * q + 1] = bfhi(r1.x); kr1[4 * q + 2] = bflo(r1.y); kr1[4 * q + 3] = bfhi(r1.y);
        kr2[4 * q] = bflo(r2.x); kr2[4 * q + 1] = bfhi(r2.x); kr2[4 * q + 2] = bflo(r2.y); kr2[4 * q + 3] = bfhi(r2.y); }
#pragma unroll
    for (int j = 0; j < 8; ++j) ssr += kr1[j] * kr1[j] + kr2[j] * kr2[j];
    ssr += __shfl_xor(ssr, 32);
#pragma unroll 1
    for (int hh = 0; hh < 2; ++hh) {
        const int head = part * 2 + hh;
        float ss = 0.f;
#pragma unroll 1
        for (int ft = 0; ft < 2; ++ft) { f32x16 acc; zero16(acc); const bf16_t* wr = Wkvb + (size_t)(head * 128 + 32 * ft + n) * 128 + 8 * h;
#pragma unroll
            for (int ks = 0; ks < 8; ++ks) { const bf16x8 wa = *(const bf16x8*)(wr + 16 * ks); acc = MFMA32(wa, ckv[ks], acc); }
#pragma unroll
            for (int i = 0; i < 16; ++i) ss += acc[i] * acc[i]; }
        ss += __shfl_xor(ss, 32);
        const float r = 1.0f / sqrtf((ss + ssr) * (1.0f / 96.0f) + EPS);
        bf16_t* dst = km + ((size_t)(b * 8 + head) * SEQ + t) * 96;
        bf16_t* vd = vmT + ((size_t)(b * 8 + head) * 64 + 4 * h) * SEQ + t;
#pragma unroll 1
        for (int ft = 0; ft < 4; ++ft) { f32x16 acc; zero16(acc); const bf16_t* wr = Wkvb + (size_t)(head * 128 + 32 * ft + n) * 128 + 8 * h;
#pragma unroll
            for (int ks = 0; ks < 8; ++ks) { const bf16x8 wa = *(const bf16x8*)(wr + 16 * ks); acc = MFMA32(wa, ckv[ks], acc); }
            if (ft < 2) {
#pragma unroll
                for (int q = 0; q < 4; ++q) { const int f = 32 * ft + 8 * q + 4 * h; const f32x4 g = *(const f32x4*)(kg + f);
                    u32x2 w; w.x = cvtpk(acc[4 * q] * r * g.x, acc[4 * q + 1] * r * g.y); w.y = cvtpk(acc[4 * q + 2] * r * g.z, acc[4 * q + 3] * r * g.w);
                    *(u32x2*)(dst + f) = w; }
            } else {
                bf16_t* vp_ = vd + (size_t)(32 * (ft - 2)) * SEQ; asm volatile("" : "+v"(vp_)); gbf16_t* vp = (gbf16_t*)vp_;
#pragma unroll
                for (int i = 0; i < 16; ++i) vp[(size_t)crow(i, 0) * SEQ] = (bf16_t)(cvtpk(acc[i], 0.f) & 0xffffu);
            }
        }
#pragma unroll
        for (int q = 0; q < 2; ++q) { const int f1 = 8 * q + 4 * h; const f32x4 g1 = *(const f32x4*)(kg + 64 + f1), g2 = *(const f32x4*)(kg + 80 + f1);
            float o1[4], o2[4];
#pragma unroll
            for (int j = 0; j < 4; ++j) { const float x1 = kr1[4 * q + j] * r * g1[j], x2 = kr2[4 * q + j] * r * g2[j]; const float cs = rope[2 * (f1 + j)], sn = rope[2 * (f1 + j) + 1];
                o1[j] = x1 * cs - x2 * sn; o2[j] = x2 * cs + x1 * sn; }
            u32x2 w; w.x = cvtpk(o1[0], o1[1]); w.y = cvtpk(o1[2], o1[3]); *(u32x2*)(dst + 64 + f1) = w;
            u32x2 w2; w2.x = cvtpk(o2[0], o2[1]); w2.y = cvtpk(o2[2], o2[3]); *(u32x2*)(dst + 80 + f1) = w2; }
    }
}

DI void norm_heads_inplace(const Ctx& C, bf16_t* z, int ld, int col0, int nheads, const float* __restrict__ gain) {
    const int sub = C.lane & 7; const long nchunks = (long)TOK * nheads;
    f32x4 g0 = *(const f32x4*)(gain + 8 * sub), g1 = *(const f32x4*)(gain + 8 * sub + 4);
    for (long c0 = (long)C.gw * 32 + (C.lane >> 3); c0 < nchunks; c0 += (long)C.NGW * 32) {
        u32x4 raw[4]; bf16_t* pp[4];
#pragma unroll
        for (int u = 0; u < 4; ++u) { const long c = c0 + 8 * u; const bool ok = c < nchunks; const long cc = ok ? c : 0;
            const int tok = (int)(cc / nheads), hd = (int)(cc % nheads);
            pp[u] = ok ? z + (size_t)tok * ld + col0 + hd * 64 + 8 * sub : nullptr;
            raw[u] = ok ? *(const u32x4*)pp[u] : (u32x4){0u, 0u, 0u, 0u}; }
#pragma unroll
        for (int u = 0; u < 4; ++u) {
            float v[8]; float ss = 0.f;
#pragma unroll
            for (int j = 0; j < 4; ++j) { v[2 * j] = bflo(raw[u][j]); v[2 * j + 1] = bfhi(raw[u][j]); ss += v[2 * j] * v[2 * j] + v[2 * j + 1] * v[2 * j + 1]; }
            ss += __shfl_xor(ss, 1); ss += __shfl_xor(ss, 2); ss += __shfl_xor(ss, 4);
            const float r = 1.0f / sqrtf(ss * (1.0f / 64.0f) + EPS);
            u32x4 w; w.x = cvtpk(v[0] * r * g0.x, v[1] * r * g0.y); w.y = cvtpk(v[2] * r * g0.z, v[3] * r * g0.w); w.z = cvtpk(v[4] * r * g1.x, v[5] * r * g1.y); w.w = cvtpk(v[6] * r * g1.z, v[7] * r * g1.w);
            if (pp[u]) *(u32x4*)pp[u] = w;
        }
    }
}
DI void vt_scatter(const Ctx& C, const bf16_t* z, int ld, int col0, int nheads, int hd_lo, int hd_n, int d, bf16_t* vT) {
    const long nitems = (long)(TOK / 64) * hd_n;
    for (long it = C.gw; it < nitems; it += C.NGW) {
        const int tile = (int)(it / hd_n), hd = hd_lo + (int)(it % hd_n);
        const int tok = tile * 64 + C.lane, b = tok >> 11, t = tok & 2047;
        const int pos = (t % d) * (SEQ / d) + t / d;
        const bf16_t* p = z + (size_t)tok * ld + col0 + hd * 64;
        bf16_t* o_ = vT + ((size_t)(b * nheads + hd) * 64) * SEQ + pos; asm volatile("" : "+v"(o_)); gbf16_t* o = (gbf16_t*)o_;
#pragma unroll
        for (int c8 = 0; c8 < 8; ++c8) { const u32x4 raw = *(const u32x4*)(p + 8 * c8);
#pragma unroll
            for (int j = 0; j < 4; ++j) { o[(size_t)(8 * c8 + 2 * j) * SEQ] = (bf16_t)(raw[j] & 0xffffu); o[(size_t)(8 * c8 + 2 * j + 1) * SEQ] = (bf16_t)(raw[j] >> 16); } }
    }
}

DI void phase_prep0(const Ctx& C, const KA& a) {
    unsigned char* ws = a.ws; bf16_t* z = (bf16_t*)(ws + WS_H);
    for (int it = C.gw; it < 4096; it += C.NGW) mla_prep_item(C, a, it);
    bf16_t* vdT = (bf16_t*)(ws + WS_VDT);
    vt_scatter(C, z, LD0, Z0_DIL + 1536, 12, 0, 4, 1, vdT);
    vt_scatter(C, z, LD0, Z0_DIL + 1536, 12, 4, 4, 4, vdT);
    vt_scatter(C, z, LD0, Z0_DIL + 1536, 12, 8, 4, 16, vdT);
    norm_heads_inplace(C, z, LD0, Z0_DIL + 768, 12, a.in(19));
}

DI const LAS float* load_t5_lds(const Ctx& C, const KA& a, int col0, int ncols) {
    __syncthreads();
    LAS float* t = (LAS float*)(C.lds + 4096); const float* src = (const float*)(a.ws + WS_T5) + col0 * TABW;
    const int n4 = ncols * TABW / 4;
    for (int i0 = C.tid; i0 < n4; i0 += 2048) {
        f32x4 v[4];
#pragma unroll
        for (int u = 0; u < 4; ++u) { const int i = i0 + 512 * u; v[u] = (i < n4) ? *(const f32x4*)(src + 4 * (size_t)i) : (f32x4){0.f, 0.f, 0.f, 0.f}; }
#pragma unroll
        for (int u = 0; u < 4; ++u) { const int i = i0 + 512 * u; if (i < n4) *(LAS f32x4*)(t + 4 * i) = v[u]; }
    }
    __syncthreads();
    return t + T5RB;
}
template <int DK, bool BIAS, bool SEL, int DSC = 1>
DI void attn_tiles_lds(f32x16& o0, f32x16& o1, float& m, float& l, const bf16x8 (&qf)[DK / 16], const char* kg, size_t kstride, const char* vg, size_t vstride,
                       int kt_lo, int kt_hi, int tq, int tq_min, int tq_max, int W, const LAS float* tab, unsigned selw, int blk_lo, int blk_hi,
                       LAS unsigned char* lds, int tile_off, int tid_in, int n, int h) {
    int tid = tid_in; asm volatile("" : "+v"(tid));
    constexpr int PK = DK * 2 + 16, PV = 136, KB = 64 * PK, BUF = KB + 64 * PV, PPR = DK / 8, NKP = 64 * PPR, NP = NKP + 512, NR = (NP + 511) / 512;
    LAS unsigned char* tbuf = lds + tile_off;
    constexpr bool PF2 = (DK == 64);
    u32x4 r[NR], r2[PF2 ? NR : 1];
#define ATL_GLOAD(kt) do { _Pragma("unroll") for (int rr = 0; rr < NR; ++rr) { const int p = tid + 512 * rr; \
        if ((512 * (rr + 1) <= NKP) || ((512 * rr < NKP) && p < NKP)) r[rr] = *(const u32x4*)(kg + (size_t)(64 * (kt) + p / PPR) * kstride + (p % PPR) * 16); \
        else if ((512 * (rr + 1) <= NP) || p < NP) r[rr] = *(const u32x4*)(vg + (size_t)((p - NKP) >> 3) * vstride + (size_t)(64 * (kt)) * 2 + ((p - NKP) & 7) * 16); } } while (0)
#define ATL_LSTORE(buf) do { LAS unsigned char* bb_ = tbuf + (buf) * BUF; _Pragma("unroll") for (int rr = 0; rr < NR; ++rr) { const int p = tid + 512 * rr; \
        if ((512 * (rr + 1) <= NKP) || ((512 * rr < NKP) && p < NKP)) *(LAS u32x4*)(bb_ + (p / PPR) * PK + (p % PPR) * 16) = r[rr]; \
        else if ((512 * (rr + 1) <= NP) || p < NP) { LAS unsigned char* d_ = bb_ + KB + ((p - NKP) >> 3) * PV + ((p - NKP) & 7) * 16; *(LAS u32x2*)d_ = (u32x2){r[rr].x, r[rr].y}; *(LAS u32x2*)(d_ + 8) = (u32x2){r[rr].z, r[rr].w}; } } } while (0)
    __syncthreads();
    ATL_GLOAD(blk_lo); ATL_LSTORE(blk_lo & 1);
    if (PF2 && blk_lo < blk_hi) ATL_GLOAD(blk_lo + 1);
#pragma unroll 1
    for (int kt = blk_lo; kt <= blk_hi; ++kt) {
        __syncthreads();
        if (!PF2) { if (kt < blk_hi) ATL_GLOAD(kt + 1); }
        else if (kt + 2 <= blk_hi) { _Pragma("unroll") for (int rr = 0; rr < NR; ++rr) { const int p = tid + 512 * rr;
            if ((512 * (rr + 1) <= NKP) || ((512 * rr < NKP) && p < NKP)) r2[rr] = *(const u32x4*)(kg + (size_t)(64 * (kt + 2) + p / PPR) * kstride + (p % PPR) * 16);
            else if ((512 * (rr + 1) <= NP) || p < NP) r2[rr] = *(const u32x4*)(vg + (size_t)((p - NKP) >> 3) * vstride + (size_t)(64 * (kt + 2)) * 2 + ((p - NKP) & 7) * 16); } }
        bool work = (kt >= kt_lo && kt <= kt_hi);
        bool selok = true;
        if (SEL) { selok = ((selw >> kt) & 1u) != 0u; if (__builtin_amdgcn_ballot_w64(selok) == 0ull) work = false; }
        if (work) {
            const LAS unsigned char* bb = tbuf + (kt & 1) * BUF;
            const int k0 = 64 * kt;
            const int dbase = tq - k0 - 4 * h;
            const LAS float* tb = tab - dbase * DSC;
            f32x16 s0, s1;
            if (BIAS) {
#pragma unroll
                for (int i = 0; i < 16; ++i) { const int c = (i & 3) + 8 * (i >> 2); s0[i] = tb[c * DSC]; s1[i] = tb[(c + 32) * DSC]; }
            } else {
#pragma unroll
                for (int i = 0; i < 16; ++i) { s0[i] = 0.f; s1[i] = 0.f; }
            }
#pragma unroll
            for (int ks = 0; ks < DK / 16; ++ks) { const bf16x8 ka = *(const LAS bf16x8*)(bb + n * PK + (16 * ks + 8 * h) * 2), kb2 = *(const LAS bf16x8*)(bb + (32 + n) * PK + (16 * ks + 8 * h) * 2);
                s0 = MFMA32(ka, qf[ks], s0); s1 = MFMA32(kb2, qf[ks], s1); }
            const bool interior = (tq_min >= k0 + 63) && (tq_max - k0 < W) && (!SEL || __builtin_amdgcn_ballot_w64(!selok) == 0ull);
            if (!interior) {
#pragma unroll
                for (int i = 0; i < 16; ++i) { const int c = (i & 3) + 8 * (i >> 2);
                    s0[i] = ((unsigned)(dbase - c) < (unsigned)W && selok) ? s0[i] : -INFINITY;
                    s1[i] = ((unsigned)(dbase - c - 32) < (unsigned)W && selok) ? s1[i] : -INFINITY; }
            }
            float mxa = max3f(s0[0], s1[0], s0[1]), mxb = max3f(s1[1], s0[2], s1[2]);
#pragma unroll
            for (int i = 3; i < 15; i += 2) { mxa = max3f(mxa, s0[i], s1[i]); mxb = max3f(mxb, s0[i + 1], s1[i + 1]); }
            float mx = max3f(mxa, mxb, max2f(s0[15], s1[15]));
            mx = max2f(mx, __shfl_xor(mx, 32));
            if (__builtin_amdgcn_ballot_w64(mx - m > 8.0f) != 0ull) {
                const float mn = fmaxf(m, mx), mu_ = (mn == -INFINITY) ? 0.f : mn;
                const float alpha = fexp2(m - mu_); m = mn; l *= alpha;
#pragma unroll
                for (int i = 0; i < 16; ++i) { o0[i] *= alpha; o1[i] *= alpha; }
            }
            const float mu = (m == -INFINITY) ? 0.f : m;
            float rs = 0.f;
#pragma unroll
            for (int i = 0; i < 16; i += 2) {
                f32x2_t a2 = {s0[i], s0[i + 1]}, b2 = {s1[i], s1[i + 1]}; const f32x2_t nm = {-mu, -mu};
                a2 = a2 + nm; b2 = b2 + nm;
                s0[i] = fexp2(a2.x); s0[i + 1] = fexp2(a2.y); s1[i] = fexp2(b2.x); s1[i + 1] = fexp2(b2.y);
                rs += (s0[i] + s0[i + 1]) + (s1[i] + s1[i + 1]); }
            l += rs;
            bf16x8 pb[4];
            { u32x4 p; p.x = cvtpk(s0[0], s0[1]); p.y = cvtpk(s0[2], s0[3]); p.z = cvtpk(s0[4], s0[5]); p.w = cvtpk(s0[6], s0[7]); pb[0] = __builtin_bit_cast(bf16x8, p);
              p.x = cvtpk(s0[8], s0[9]); p.y = cvtpk(s0[10], s0[11]); p.z = cvtpk(s0[12], s0[13]); p.w = cvtpk(s0[14], s0[15]); pb[1] = __builtin_bit_cast(bf16x8, p);
              p.x = cvtpk(s1[0], s1[1]); p.y = cvtpk(s1[2], s1[3]); p.z = cvtpk(s1[4], s1[5]); p.w = cvtpk(s1[6], s1[7]); pb[2] = __builtin_bit_cast(bf16x8, p);
              p.x = cvtpk(s1[8], s1[9]); p.y = cvtpk(s1[10], s1[11]); p.z = cvtpk(s1[12], s1[13]); p.w = cvtpk(s1[14], s1[15]); pb[3] = __builtin_bit_cast(bf16x8, p); }
            const LAS unsigned char* vb = bb + KB + n * PV + 8 * h;
#pragma unroll
            for (int sx = 0; sx < 4; ++sx) {
                const s16x4 a0 = *(const LAS s16x4*)(vb + 32 * sx), a1 = *(const LAS s16x4*)(vb + 32 * sx + 16);
                const s16x4 b0 = *(const LAS s16x4*)(vb + 32 * PV + 32 * sx), b1 = *(const LAS s16x4*)(vb + 32 * PV + 32 * sx + 16);
                o0 = MFMA32(__builtin_shufflevector(a0, a1, 0, 1, 2, 3, 4, 5, 6, 7), pb[sx], o0);
                o1 = MFMA32(__builtin_shufflevector(b0, b1, 0, 1, 2, 3, 4, 5, 6, 7), pb[sx], o1);
            }
        }
        if (kt < blk_hi) ATL_LSTORE((kt + 1) & 1);
        if (PF2) {
#pragma unroll
            for (int rr = 0; rr < NR; ++rr) r[rr] = r2[rr];
        }
    }
#undef ATL_GLOAD
#undef ATL_LSTORE
}

DI void phase_att0(const Ctx& C, const KA& a) {
    unsigned char* ws = a.ws; const int n = C.n, h = C.h;
    bf16_t* z = (bf16_t*)(ws + WS_H);
    for (int prep_ = 0; prep_ < ((PROBE_SUB == 1) ? 2 : 1); ++prep_) {
        const bf16_t* qm = (const bf16_t*)(ws + WS_QM); const bf16_t* km = (const bf16_t*)(ws + WS_KM); const bf16_t* vmT = (const bf16_t*)(ws + WS_VMT);
        for (int it = 0;; ++it) {
            const int ge = deal(it, (int)blockIdx.x, C.G, 1024); if (ge < 0) { if ((long)it * C.G >= 1024) break; else continue; }
            const int qg = ge >> 7, bh = ge & 127, b = bh >> 3, head = bh & 7, qt = 8 * qg + C.wave;
            const int t = 32 * qt + n;
            bf16x8 qf[6];
            const bf16_t* qr = qm + ((size_t)bh * SEQ + t) * 96 + 8 * h;
#pragma unroll
            for (int ks = 0; ks < 6; ++ks) qf[ks] = *(const bf16x8*)(qr + 16 * ks);
            f32x16 o0, o1; zero16(o0); zero16(o1); float m = -INFINITY, l = 0.f;
            attn_tiles_lds<96, false, false>(o0, o1, m, l, qf, (const char*)(km + (size_t)bh * SEQ * 96), 192, (const char*)(vmT + (size_t)bh * 64 * SEQ), (size_t)SEQ * 2,
                                             0, qt >> 1, t, 32 * qt, 32 * qt + 31, 1 << 30, (const LAS float*)C.lds, 0u, 0, 4 * qg + 3, C.lds, 4096, C.tid, n, h);
            l += __shfl_xor(l, 32);
            store_o64(z + (size_t)(b * SEQ + t) * LD0 + Z0_MIX + head * 64, o0, o1, 1.0f / l, h);
        }
    }
    for (int prep_ = 0; prep_ < ((PROBE_SUB == 2) ? 2 : 1); ++prep_) {
        const LAS float* t5 = load_t5_lds(C, a, 0, 12);
        const bf16_t* vdT = (const bf16_t*)(ws + WS_VDT); bf16_t* og = (bf16_t*)(a.outb + OUT_OG); float* lse = (float*)(a.outb + OUT_LSE);
        const float* qg = a.in(18);
        for (int unit = (int)blockIdx.x; unit < 2048; unit += C.G) {
            int g, rem; if (unit < 512) { g = 0; rem = unit; } else if (unit < 1024) { g = 1; rem = unit - 512; } else { g = 2; rem = unit - 1024; }
            const int d = (g == 0) ? 1 : (g == 1 ? 4 : 16), Sd = SEQ / d;
            const int upbh = (g == 2) ? 16 : 8;
            const int bhh = rem / upbh, sub = rem % upbh, b = bhh >> 2, hgi = bhh & 3;
            const int spr = (g == 0) ? 8 : (g == 1 ? 2 : 1);
            const int r = sub / spr, pg = sub % spr;
            const int head12 = g * 4 + hgi, pt = 8 * pg + C.wave;
            const bool active = (32 * pt) < Sd;
            const int tp = active ? 32 * pt + n : n, tok = b * SEQ + tp * d + r;
            bf16x8 qf[4];
            load_q64(qf, z + (size_t)tok * LD0 + Z0_DIL + head12 * 64, qg, 0.125f * LOG2E, h);
            f32x16 o0, o1; zero16(o0); zero16(o1); float m = -INFINITY, l = 0.f;
            const int blo64 = (256 * pg - 128) > 0 ? ((256 * pg - 128) >> 6) : 0; const int bhi_ = 4 * pg + 3, bmax = Sd / 64 - 1; const int bhi64 = bhi_ < bmax ? bhi_ : bmax;
            int klo = (32 * pt - 128) > 0 ? ((32 * pt - 128) >> 6) : 0, khi = (32 * pt + 31) >> 6; if (!active) { klo = 1; khi = 0; }
            const char* kg = (const char*)(z + (size_t)(b * SEQ + r) * LD0 + Z0_DIL + 768 + head12 * 64);
            const char* vg = (const char*)(vdT + ((size_t)(b * 12 + head12) * 64) * SEQ + r * Sd);
            const LAS float* tab = t5 + head12 * TABW;
            if (g == 0) attn_tiles_lds<64, true, false, 1>(o0, o1, m, l, qf, kg, (size_t)LD0 * 2, vg, (size_t)SEQ * 2, klo, khi, tp, 32 * pt, 32 * pt + 31, 129, tab, 0u, blo64, bhi64, C.lds, 106496, C.tid, n, h);
            else if (g == 1) attn_tiles_lds<64, true, false, 4>(o0, o1, m, l, qf, kg, (size_t)LD0 * 8, vg, (size_t)SEQ * 2, klo, khi, tp, 32 * pt, 32 * pt + 31, 129, tab, 0u, blo64, bhi64, C.lds, 106496, C.tid, n, h);
            else attn_tiles_lds<64, true, false, 16>(o0, o1, m, l, qf, kg, (size_t)LD0 * 32, vg, (size_t)SEQ * 2, klo, khi, tp, 32 * pt, 32 * pt + 31, 129, tab, 0u, blo64, bhi64, C.lds, 106496, C.tid, n, h);
            if (active) {
                l += __shfl_xor(l, 32);
                store_o64(og + (((size_t)g * TOK + tok) * 4 + hgi) * 64, o0, o1, 1.0f / l, h);
                if (h == 0) lse[((size_t)g * TOK + tok) * 4 + hgi] = m + log2f(l);
            }
        }
    }
}

DI void phase_comb0(const Ctx& C, const KA& a) {
    unsigned char* ws = a.ws; bf16_t* z = (bf16_t*)(ws + WS_H);
    const bf16_t* og = (const bf16_t*)(a.outb + OUT_OG); const float* lse = (const float*)(a.outb + OUT_LSE);
    const long total = (long)TOK * 4 * 8;
    for (long i = (long)C.gw * 64 + C.lane; i < total; i += (long)C.NGW * 64) {
        const int c8 = (int)(i & 7); const long th = i >> 3; const int hg = (int)(th & 3); const int tok = (int)(th >> 2);
        const float l0 = lse[(size_t)tok * 4 + hg], l1 = lse[((size_t)TOK + tok) * 4 + hg], l2 = lse[((size_t)2 * TOK + tok) * 4 + hg];
        const float mx = fmaxf(l0, fmaxf(l1, l2));
        float w0 = fexp2(l0 - mx), w1 = fexp2(l1 - mx), w2 = fexp2(l2 - mx); const float inv = 1.0f / (w0 + w1 + w2); w0 *= inv; w1 *= inv; w2 *= inv;
        const u32x4 a0 = *(const u32x4*)(og + ((size_t)tok * 4 + hg) * 64 + 8 * c8), a1 = *(const u32x4*)(og + (((size_t)TOK + tok) * 4 + hg) * 64 + 8 * c8), a2 = *(const u32x4*)(og + (((size_t)2 * TOK + tok) * 4 + hg) * 64 + 8 * c8);
        u32x4 w;
#pragma unroll
        for (int j = 0; j < 4; ++j) w[j] = cvtpk(w0 * bflo(a0[j]) + w1 * bflo(a1[j]) + w2 * bflo(a2[j]), w0 * bfhi(a0[j]) + w1 * bfhi(a1[j]) + w2 * bfhi(a2[j]));
        *(u32x4*)(z + (size_t)tok * LD0 + Z0_MIX + 512 + hg * 64 + 8 * c8) = w;
    }
}

constexpr int Z1_SQ = 0, Z1_SK = 512, Z1_SV = 640, Z1_NQ = 768, Z1_KC = 1280, Z1_VC = 1408, Z1_KS = 1536, Z1_VS = 1664, Z1_KW = 1792, Z1_VW = 1920, Z1_G = 2048;

DI float gelu_tanh(float x) {
    const float u = 0.7978845608028654f * (x + 0.044715f * x * x * x);
    const float e = fexp2(-2.0f * LOG2E * fabsf(u)); const float th = (1.0f - e) * frcp(1.0f + e);
    return 0.5f * x * (1.0f + (u < 0.f ? -th : th));
}
DI void cmp_item(const Ctx& C, const KA& a, int item) {
    unsigned char* ws = a.ws; const int n = C.n, h = C.h;
    const int ct = item & 3, which = (item >> 2) & 1, g = (item >> 3) & 1, b = item >> 4;
    const bf16_t* z = (const bf16_t*)(ws + WS_H);
    int c = 32 * ct + n; const int cl = c < 127 ? c : 126;
    const bf16_t* zr = z + (size_t)(b * SEQ + 16 * cl) * LD1 + (which ? Z1_VC : Z1_KC) + g * 64 + 8 * h;
    const bf16_t* W1 = (const bf16_t*)(ws + WS_WC1) + (size_t)which * 128 * 2048; const bf16_t* W2 = (const bf16_t*)(ws + WS_WC2) + (size_t)which * 64 * 128;
    f32x16 hid[4];
#pragma unroll
    for (int ft = 0; ft < 4; ++ft) zero16(hid[ft]);
#pragma unroll 1
    for (int lq = 0; lq < 4; ++lq) {
        const int lt = 4 * C.wave + lq;
#pragma unroll
        for (int ks = 0; ks < 4; ++ks) {
            const bf16x8 bq = *(const bf16x8*)(zr + (size_t)lt * LD1 + 16 * ks);
#pragma unroll
            for (int ft = 0; ft < 4; ++ft) { const bf16x8 wa = *(const bf16x8*)(W1 + (size_t)(32 * ft + n) * 2048 + lt * 64 + 16 * ks + 8 * h); hid[ft] = MFMA32(wa, bq, hid[ft]); }
        }
    }
    LAS float* part = (LAS float*)C.lds;
    __syncthreads();
#pragma unroll
    for (int ft = 0; ft < 4; ++ft)
#pragma unroll
        for (int i = 0; i < 16; ++i) part[((C.wave * 4 + ft) * 16 + i) * 64 + C.lane] = hid[ft][i];
    __syncthreads();
    if (C.wave != 0) return;
#pragma unroll
    for (int ft = 0; ft < 4; ++ft)
#pragma unroll
        for (int i = 0; i < 16; ++i) { float t = 0.f;
#pragma unroll
            for (int w = 0; w < 8; ++w) t += part[((w * 4 + ft) * 16 + i) * 64 + C.lane];
            hid[ft][i] = t; }
    const float* cb = (const float*)(ws + WS_CB) + which * 128;
    f32x16 o0, o1; zero16(o0); zero16(o1);
#pragma unroll
    for (int ft = 0; ft < 4; ++ft) {
        float gv[16];
#pragma unroll
        for (int i = 0; i < 16; ++i) gv[i] = gelu_tanh(hid[ft][i] + cb[32 * ft + crow(i, h)]);
#pragma unroll
        for (int s = 0; s < 2; ++s) {
            u32x4 p; p.x = cvtpk(gv[8 * s], gv[8 * s + 1]); p.y = cvtpk(gv[8 * s + 2], gv[8 * s + 3]); p.z = cvtpk(gv[8 * s + 4], gv[8 * s + 5]); p.w = cvtpk(gv[8 * s + 6], gv[8 * s + 7]);
            const bf16x8 pb = __builtin_bit_cast(bf16x8, p);
            const bf16_t* w2 = W2 + (size_t)n * 128 + 32 * ft + 16 * s + 4 * h;
            const s16x4 a0 = *(const s16x4*)(w2), a1 = *(const s16x4*)(w2 + 8);
            const s16x4 b0 = *(const s16x4*)(w2 + 32 * 128), b1 = *(const s16x4*)(w2 + 32 * 128 + 8);
            o0 = MFMA32(__builtin_shufflevector(a0, a1, 0, 1, 2, 3, 4, 5, 6, 7), pb, o0);
            o1 = MFMA32(__builtin_shufflevector(b0, b1, 0, 1, 2, 3, 4, 5, 6, 7), pb, o1);
        }
    }
    if (which == 0) {
        float ss = 0.f;
#pragma unroll
        for (int i = 0; i < 16; ++i) ss += o0[i] * o0[i] + o1[i] * o1[i];
        ss += __shfl_xor(ss, 32);
        const float r = 1.0f / sqrtf(ss * (1.0f / 64.0f) + EPS);
        const float* kg = a.in(26);
        bf16_t* dst = (bf16_t*)(ws + WS_KC) + ((size_t)(b * 2 + g) * 128 + c) * 64;
#pragma unroll
        for (int q = 0; q < 4; ++q) { const int f = 8 * q + 4 * h; const f32x4 g0 = *(const f32x4*)(kg + f), g1 = *(const f32x4*)(kg + 32 + f);
            u32x2 w; w.x = cvtpk(o0[4 * q] * r * g0.x, o0[4 * q + 1] * r * g0.y); w.y = cvtpk(o0[4 * q + 2] * r * g0.z, o0[4 * q + 3] * r * g0.w); *(u32x2*)(dst + f) = w;
            u32x2 w2; w2.x = cvtpk(o1[4 * q] * r * g1.x, o1[4 * q + 1] * r * g1.y); w2.y = cvtpk(o1[4 * q + 2] * r * g1.z, o1[4 * q + 3] * r * g1.w); *(u32x2*)(dst + 32 + f) = w2; }
    } else {
        bf16_t* dst_ = (bf16_t*)(ws + WS_VCT) + ((size_t)(b * 2 + g) * 64 + 4 * h) * 128 + c; asm volatile("" : "+v"(dst_)); gbf16_t* dst = (gbf16_t*)dst_;
#pragma unroll
        for (int i = 0; i < 16; ++i) { dst[(size_t)crow(i, 0) * 128] = (bf16_t)(cvtpk(o0[i], 0.f) & 0xffffu); dst[(size_t)(32 + crow(i, 0)) * 128] = (bf16_t)(cvtpk(o1[i], 0.f) & 0xffffu); }
    }
}

DI void phase_prep1(const Ctx& C, const KA& a) {
    unsigned char* ws = a.ws; bf16_t* z = (bf16_t*)(ws + WS_H);
    for (int it = (int)blockIdx.x; it < 256; it += C.G) cmp_item(C, a, it);
    bf16_t* vt = (bf16_t*)(ws + WS_VT1); const size_t VTS = (size_t)BATCH * 2 * 64 * SEQ;
    vt_scatter(C, z, LD1, Z1_SV, 2, 0, 2, 1, vt);
    vt_scatter(C, z, LD1, Z1_VS, 2, 0, 2, 1, vt + VTS);
    vt_scatter(C, z, LD1, Z1_VW, 2, 0, 2, 1, vt + 2 * VTS);
    norm_heads_inplace(C, z, LD1, Z1_SK, 2, a.in(23));
    norm_heads_inplace(C, z, LD1, Z1_KS, 2, a.in(26) + 64);
    norm_heads_inplace(C, z, LD1, Z1_KW, 2, a.in(26) + 128);
}

DI float quad_sum(float v) {
    v += __builtin_bit_cast(float, __builtin_amdgcn_update_dpp(0, __builtin_bit_cast(int, v), 0xB1, 0xf, 0xf, true));
    v += __builtin_bit_cast(float, __builtin_amdgcn_update_dpp(0, __builtin_bit_cast(int, v), 0x4E, 0xf, 0xf, true));
    return v; }

DI void phase_att1(const Ctx& C, const KA& a) {
    unsigned char* ws = a.ws; const int n = C.n, h = C.h, r = n & 3, tl = n >> 2;
    const LAS float* t5 = load_t5_lds(C, a, 8, 8);
    const bf16_t* z = (const bf16_t*)(ws + WS_H); bf16_t* mixed = (bf16_t*)(ws + WS_MIX1);
    const bf16_t* vt = (const bf16_t*)(ws + WS_VT1); const size_t VTS = (size_t)BATCH * 2 * 64 * SEQ;
    const float qsc = 0.125f * LOG2E;
    for (int prep_ = 0; prep_ < ((PROBE_SUB == 3) ? 2 : 1); ++prep_)
    for (int it = 0;; ++it) {
        const int ge = deal(it, (int)blockIdx.x, C.G, 1024); if (ge < 0) { if ((long)it * C.G >= 1024) break; else continue; }
        const int tg = ge >> 5, bg = ge & 31, b = bg >> 1, g = bg & 1, head = g * 4 + r, tt = 8 * tg + C.wave;
        const int t = 8 * tt + tl, tok = b * SEQ + t;
        bf16x8 qf[4];
        load_q64(qf, z + (size_t)tok * LD1 + Z1_NQ + head * 64, a.in(25), qsc, h);
        const bf16_t* gz = z + (size_t)tok * LD1 + Z1_G + head * 3;
        const float g_cmp = frcp(1.0f + fexp2(-LOG2E * bf2f(gz[0]))), g_slc = frcp(1.0f + fexp2(-LOG2E * bf2f(gz[1]))), g_win = frcp(1.0f + fexp2(-LOG2E * bf2f(gz[2])));
        f32x16 r0, r1;
        unsigned selw;
        {
            constexpr int CKP = 144, CVP = 264, CVOFF = 128 * CKP;
            LAS unsigned char* cbuf = C.lds + 73728;
            __syncthreads();
            {
                const unsigned char* kcg = (const unsigned char*)((const bf16_t*)(ws + WS_KC) + (size_t)bg * 128 * 64);
                const unsigned char* vcg = (const unsigned char*)((const bf16_t*)(ws + WS_VCT) + (size_t)bg * 64 * 128);
#pragma unroll
                for (int rr = 0; rr < 2; ++rr) { const int p = C.tid + 512 * rr;
                    const u32x4 kv = *(const u32x4*)(kcg + (size_t)p * 16); *(LAS u32x4*)(cbuf + (p >> 3) * CKP + (p & 7) * 16) = kv;
                    const u32x4 vv = *(const u32x4*)(vcg + (size_t)p * 16); LAS unsigned char* dv = cbuf + CVOFF + (p >> 4) * CVP + (p & 15) * 16;
                    *(LAS u32x2*)dv = (u32x2){vv.x, vv.y}; *(LAS u32x2*)(dv + 8) = (u32x2){vv.z, vv.w}; }
            }
            __syncthreads();
            const LAS unsigned char* kc = cbuf + n * CKP + 16 * h;
            const LAS unsigned char* vc = cbuf + CVOFF + n * CVP + 8 * h;
            const int cmax = (t >= 31) ? ((t - 31) >> 4) : -1;
            float mx = -INFINITY;
#pragma unroll
            for (int kt = 0; kt < 4; ++kt) { f32x16 s; zero16(s); int lim = cmax - 4 * h; asm volatile("" : "+v"(lim));
#pragma unroll
                for (int ks = 0; ks < 4; ++ks) { const bf16x8 ka = *(const LAS bf16x8*)(kc + kt * 32 * CKP + 32 * ks); s = MFMA32(ka, qf[ks], s); }
#pragma unroll
                for (int i = 0; i < 16; ++i) { const int c = 32 * kt + crow(i, 0); mx = fmaxf(mx, (c <= lim) ? s[i] : -INFINITY); }
                asm volatile("" ::: "memory"); }
            mx = fmaxf(mx, __shfl_xor(mx, 32));
            const float mu = (mx == -INFINITY) ? 0.f : mx; float sum = 0.f;
#pragma unroll
            for (int kt = 0; kt < 4; ++kt) { f32x16 s; zero16(s); int lim = cmax - 4 * h; asm volatile("" : "+v"(lim));
#pragma unroll
                for (int ks = 0; ks < 4; ++ks) { const bf16x8 ka = *(const LAS bf16x8*)(kc + kt * 32 * CKP + 32 * ks); s = MFMA32(ka, qf[ks], s); }
#pragma unroll
                for (int i = 0; i < 16; ++i) { const int c = 32 * kt + crow(i, 0); sum += (c <= lim) ? fexp2(s[i] - mu) : 0.f; }
                asm volatile("" ::: "memory"); }
            sum += __shfl_xor(sum, 32);
            const float inv = 1.0f / fmaxf(sum, 1e-30f);
            float own[16], lastv[16];
            f32x16 o0, o1; zero16(o0); zero16(o1);
#pragma unroll
            for (int kt = 0; kt < 4; ++kt) { f32x16 s; zero16(s); int lim = cmax - 4 * h; asm volatile("" : "+v"(lim));
#pragma unroll
                for (int ks = 0; ks < 4; ++ks) { const bf16x8 ka = *(const LAS bf16x8*)(kc + kt * 32 * CKP + 32 * ks); s = MFMA32(ka, qf[ks], s); }
#pragma unroll
                for (int i = 0; i < 16; ++i) { const int c = 32 * kt + crow(i, 0); s[i] = (c <= lim) ? fexp2(s[i] - mu) * inv : 0.f; }
#pragma unroll
                for (int q = 0; q < 4; ++q) { const float p3 = quad_sum(s[4 * q + 3]); const float p012 = quad_sum(s[4 * q] + s[4 * q + 1] + s[4 * q + 2]); own[4 * kt + q] = p012 + p3; lastv[4 * kt + q] = p3; }
#pragma unroll
                for (int sx = 0; sx < 2; ++sx) {
                    u32x4 p; p.x = cvtpk(s[8 * sx], s[8 * sx + 1]); p.y = cvtpk(s[8 * sx + 2], s[8 * sx + 3]); p.z = cvtpk(s[8 * sx + 4], s[8 * sx + 5]); p.w = cvtpk(s[8 * sx + 6], s[8 * sx + 7]);
                    const bf16x8 pb = __builtin_bit_cast(bf16x8, p);
                    const LAS unsigned char* vp = vc + 64 * kt + 32 * sx;
                    const s16x4 a0 = *(const LAS s16x4*)(vp), a1 = *(const LAS s16x4*)(vp + 16), b0 = *(const LAS s16x4*)(vp + 32 * CVP), b1 = *(const LAS s16x4*)(vp + 32 * CVP + 16);
                    o0 = MFMA32(__builtin_shufflevector(a0, a1, 0, 1, 2, 3, 4, 5, 6, 7), pb, o0);
                    o1 = MFMA32(__builtin_shufflevector(b0, b1, 0, 1, 2, 3, 4, 5, 6, 7), pb, o1);
                }
                asm volatile("" ::: "memory"); }
#pragma unroll
            for (int i = 0; i < 16; ++i) { r0[i] = g_cmp * o0[i]; r1[i] = g_cmp * o1[i]; }
            float imp[32];
#pragma unroll
            for (int idx = 0; idx < 16; ++idx) {
                const float rl = __shfl_xor(lastv[idx], 32);
                const float rlm = (idx > 0) ? __shfl_xor(lastv[idx > 0 ? idx - 1 : 0], 32) : 0.f;
                const float mine = own[idx] + (h ? rl : rlm);
                const float theirs = __shfl_xor(mine, 32);
                imp[2 * idx] = h ? theirs : mine; imp[2 * idx + 1] = h ? mine : theirs;
            }
            const int tb = tt >> 3;
            if (tb <= 15) selw = (2u << tb) - 1u;
            else {
                unsigned sel = 1u | (1u << tb) | (1u << (tb - 1));
#pragma unroll
                for (int j2 = 0; j2 < 32; ++j2) imp[j2] = (j2 >= 1 && j2 <= tb - 2) ? imp[j2] : -1.0f;
#pragma unroll 1
                for (int j = 1; j <= tb - 2; ++j) {
                    float ij = 0.f;
#pragma unroll
                    for (int j2 = 1; j2 < 30; ++j2) ij = (j2 == j) ? imp[j2] : ij;
                    int rank = 0;
#pragma unroll
                    for (int j2 = 1; j2 < 30; ++j2) rank += ((j2 < j) ? (imp[j2] >= ij) : (imp[j2] > ij)) ? 1 : 0;
                    if (rank < 13) sel |= (1u << j);
                }
                selw = sel;
            }
        }
        {
            f32x16 o0, o1; zero16(o0); zero16(o1); float m = -INFINITY, l = 0.f;
            attn_tiles_lds<64, true, true>(o0, o1, m, l, qf, (const char*)(z + (size_t)(b * SEQ) * LD1 + Z1_KS + g * 64), (size_t)LD1 * 2, (const char*)(vt + VTS + (size_t)bg * 64 * SEQ), (size_t)SEQ * 2,
                                           0, tg, t, 8 * tt, 8 * tt + 7, 1 << 30, t5 + head * TABW, selw, 0, tg, C.lds, 73728, C.tid, n, h);
            l += __shfl_xor(l, 32); const float sc = g_slc / l;
#pragma unroll
            for (int i = 0; i < 16; ++i) { r0[i] += sc * o0[i]; r1[i] += sc * o1[i]; }
        }
        {
            f32x16 o0, o1; zero16(o0); zero16(o1); float m = -INFINITY, l = 0.f;
            const int wlo = tg > 8 ? tg - 8 : 0;
            attn_tiles_lds<64, true, false>(o0, o1, m, l, qf, (const char*)(z + (size_t)(b * SEQ) * LD1 + Z1_KW + g * 64), (size_t)LD1 * 2, (const char*)(vt + 2 * VTS + (size_t)bg * 64 * SEQ), (size_t)SEQ * 2,
                                            wlo, tg, t, 8 * tt, 8 * tt + 7, 512, t5 + head * TABW, 0u, wlo, tg, C.lds, 73728, C.tid, n, h);
            l += __shfl_xor(l, 32); const float sc = g_win / l;
#pragma unroll
            for (int i = 0; i < 16; ++i) { r0[i] += sc * o0[i]; r1[i] += sc * o1[i]; }
        }
        { int tok2 = b * SEQ + t; asm volatile("" : "+v"(tok2));
          store_o64(mixed + (size_t)tok2 * DM + 512 + head * 64, r0, r1, 1.0f, h); }
    }
    for (int prep_ = 0; prep_ < ((PROBE_SUB == 4) ? 2 : 1); ++prep_) {
        t5 = load_t5_lds(C, a, 0, 8);
        const float* sinks = a.in(24);
        for (int gi = (int)blockIdx.x; gi < 1024; gi += C.G) {
            const int tg = gi >> 5, bg = gi & 31, b = bg >> 1, g = bg & 1, head = g * 4 + r, tt = 8 * tg + C.wave;
            const int t = 8 * tt + tl, tok = b * SEQ + t;
            bf16x8 qf[4];
            load_q64(qf, z + (size_t)tok * LD1 + Z1_SQ + head * 64, a.in(22), qsc, h);
            f32x16 o0, o1; zero16(o0); zero16(o1); float m = -INFINITY, l = 0.f;
            const int wlo = tg > 2 ? tg - 2 : 0;
            attn_tiles_lds<64, true, false>(o0, o1, m, l, qf, (const char*)(z + (size_t)(b * SEQ) * LD1 + Z1_SK + g * 64), (size_t)LD1 * 2, (const char*)(vt + (size_t)bg * 64 * SEQ), (size_t)SEQ * 2,
                                            wlo, tg, t, 8 * tt, 8 * tt + 7, 128, t5 + head * TABW, 0u, wlo, tg, C.lds, 73728, C.tid, n, h);
            l += __shfl_xor(l, 32);
            const float sk = sinks[head] * LOG2E; const float mf = fmaxf(m, sk);
            const float den = l * fexp2(m - mf) + fexp2(sk - mf);
            store_o64(mixed + (size_t)tok * DM + head * 64, o0, o1, fexp2(m - mf) / den, h);
        }
    }
}


constexpr size_t WS_CTL = WS_SMALL + 6 * MiB;
constexpr int LDS_BAR_OFF = 147456 - 64;
#define XB_TMO      128
#define XB_XCNT(j)  (256  + 64 * (j))
#define XB_XSUB(j)  (1280 + 64 * (j))
#define XB_XGEN(j)  (2304 + 64 * (j))
#define XB_TOP      3328
#define XB_TOPGEN   3392
#define XCD_BAR_WORDS 3456
#define XB_SPIN_CAP (1u << 26)
DI unsigned xb_ld(unsigned* p)              { return __hip_atomic_load(p, __ATOMIC_RELAXED, __HIP_MEMORY_SCOPE_AGENT); }
DI unsigned xb_add(unsigned* p, unsigned v) { return __hip_atomic_fetch_add(p, v, __ATOMIC_RELAXED, __HIP_MEMORY_SCOPE_AGENT); }
DI unsigned xb_xcc_id() { return (unsigned)__builtin_amdgcn_s_getreg((3 << 11) | 20) & 0xFu; }
#define XB_SPIN(cond, bar) do { unsigned _sp = 0; while (cond) { __builtin_amdgcn_s_sleep(1); \
    if ((++_sp & 255u) == 0u) { if (xb_ld(&(bar)[XB_TMO])) break; if (_sp > XB_SPIN_CAP) { atomicAdd(&(bar)[XB_TMO], 1u); break; } } } } while (0)
struct XcdBarrier { unsigned* bar; unsigned x; volatile LAS unsigned* st; };
DI XcdBarrier xcd_barrier_post(unsigned* bar, volatile LAS unsigned* st) {
    XcdBarrier b; b.bar = bar; b.x = xb_xcc_id(); b.st = st;
    if (threadIdx.x == 0) (void)xb_add(&bar[XB_XCNT(b.x)], 1u);
    return b;
}
DI void xcd_barrier_complete(unsigned* bar, unsigned x, unsigned& nloc, unsigned& nx) {
    const unsigned G = gridDim.x * gridDim.y * gridDim.z;
    unsigned sum, cnt, mine, sp = 0u;
    for (;;) {
        sum = 0u; cnt = 0u; mine = 0u;
#pragma unroll
        for (unsigned j = 0; j < 16; ++j) { const unsigned c = xb_ld(&bar[XB_XCNT(j)]); sum += c; cnt += (c > 0u) ? 1u : 0u; mine = (j == x) ? c : mine; }
        if (sum == G) break;
        __builtin_amdgcn_s_sleep(1);
        if ((++sp & 255u) == 0u) { if (xb_ld(&bar[XB_TMO])) break; if (sp > XB_SPIN_CAP) { atomicAdd(&bar[XB_TMO], 1u); break; } }
    }
    nloc = mine > 0u ? mine : 1u; nx = cnt > 0u ? cnt : 1u;
}
DI void xcd_barrier(const XcdBarrier& b) {
    asm volatile("s_waitcnt vmcnt(0)" ::: "memory");
    __syncthreads();
    if (threadIdx.x == 0) {
        unsigned* bar = b.bar;
        __builtin_amdgcn_s_waitcnt(0);
        unsigned nloc = b.st[0], nx = b.st[1];
        if (nloc == 0u) { xcd_barrier_complete(bar, b.x, nloc, nx); b.st[0] = nloc; b.st[1] = nx; }
        const unsigned old = xb_add(&bar[XB_XSUB(b.x)], 1u);
        const unsigned gen = old / nloc;
        if (old + 1u == (gen + 1u) * nloc) {
            __builtin_amdgcn_fence(__ATOMIC_RELEASE, "agent");
            asm volatile("s_waitcnt vmcnt(0)" ::: "memory");
            const unsigned og = xb_add(&bar[XB_TOP], 1u);
            const unsigned tg = og / nx;
            if (og + 1u == (tg + 1u) * nx) xb_add(&bar[XB_TOPGEN], 1u);
            else XB_SPIN(xb_ld(&bar[XB_TOPGEN]) == tg, bar);
            __builtin_amdgcn_fence(__ATOMIC_ACQUIRE, "agent");
            xb_add(&bar[XB_XGEN(b.x)], 1u);
            asm volatile("s_waitcnt vmcnt(0)" ::: "memory");
        } else {
            XB_SPIN(xb_ld(&bar[XB_XGEN(b.x)]) == gen, bar);
            __builtin_amdgcn_fence(__ATOMIC_ACQUIRE, "agent");
            asm volatile("s_waitcnt vmcnt(0)" ::: "memory");
        }
    }
    __syncthreads();
}

constexpr int NPHASE = 18;
#ifndef PROBE_PH
#define PROBE_PH (-1)
#endif
#define PHON(k) (((MASK) >> (k)) & 1)
constexpr int LDS_BYTES = 147456;

template <int MASK> __global__ void __launch_bounds__(512, 2) mega_fwd(Args a) {
    extern __shared__ __attribute__((aligned(16))) unsigned char lds_raw[];
    cg::grid_group grid = cg::this_grid();
    if (a.ph_hi - a.ph_lo > 1) {
        volatile LAS unsigned* st = (volatile LAS unsigned*)((LAS unsigned char*)lds_raw + LDS_BAR_OFF);
        if (threadIdx.x < 2) st[threadIdx.x] = 0u;
        __syncthreads();
        (void)xcd_barrier_post((unsigned*)(a.ws + WS_CTL), st);
        grid.sync();
    }
    for (int ph = a.ph_lo; ph < a.ph_hi; ++ph) {
#define MKCTX() Ctx C; { int tid_ = threadIdx.x; asm volatile("" : "+v"(tid_)); C.lds = (LAS unsigned char*)lds_raw; C.tid = tid_; C.lane = C.tid & 63; C.wave = __builtin_amdgcn_readfirstlane(C.tid >> 6); \
        C.n = C.lane & 31; C.h = C.lane >> 5; { int G_ = gridDim.x; asm volatile("" : "+s"(G_)); C.G = G_; } C.gw = blockIdx.x * 8 + C.wave; C.NGW = C.G * 8; }
        KA ka; ka.k = (kptr_t)__builtin_amdgcn_kernarg_segment_ptr(); asm volatile("" : "+s"(ka.k));
        ka.ws = *(unsigned char* const __attribute__((address_space(4)))*)(ka.k + 256); float* outp = *(float* const __attribute__((address_space(4)))*)(ka.k + 248);
        ka.outb = (unsigned char*)outp;
        unsigned char* ws = ka.ws;
        float* rss = (float*)(ws + WS_RSS); bf16_t* xb = (bf16_t*)(ws + WS_XB); bf16_t* Hb = (bf16_t*)(ws + WS_H);
        for (int rep = 0; rep < ((ph == PROBE_PH) ? 2 : 1); ++rep) {
        int kind, arg = 0;
        switch (ph) {
            case 0: kind = 0; break;
            case 1: kind = 1; arg = 0; break;    case 2: kind = 2; arg = 0; break;
            case 3: kind = 3; arg = 0; break;    case 4: kind = 4; break;   case 5: kind = 5; break;   case 6: kind = 6; break;
            case 7: kind = 2; arg = 4; break;
            case 8: kind = 1; arg = 1; break;    case 9: kind = 2; arg = 1; break;
            case 10: kind = 1; arg = 2; break;   case 11: kind = 2; arg = 2; break;
            case 12: kind = 3; arg = 1; break;   case 13: kind = 7; break;  case 14: kind = 8; break;
            case 15: kind = 2; arg = 5; break;
            case 16: kind = 1; arg = 3; break;   default: kind = 2; arg = 3; break;
        }
        if (kind == 0) { if (PHON(0)) { MKCTX(); phase_prologue(C, ka); } }
        else if (kind == 1) { if (PHON(1)) { MKCTX();
                        pg8::Gemm g{xb, (const bf16_t*)(ws + WS_WGU) + (size_t)arg * 5632 * 1024, TOK, 5632, DM, DM};
            pg8::StaticOrder S; S.init(TOK, 5632, C.G, (int)blockIdx.x);
            pg8::EpiSwiglu E{rss, Hb};
            pg8::gemm_phase<pg8::EpiSwiglu>(C.lds, C.tid, g, S, E); }
        } else if (kind == 2) { if (PHON(2)) { MKCTX();
            pg8::Gemm g; pg8::EpiResid E;
            E.out = nullptr; E.base = nullptr; E.baseb = xb; E.xb = xb; E.alpha = 0.5f;
            if (arg < 4) { g = pg8::Gemm{Hb, (const bf16_t*)(ws + WS_WDN) + (size_t)arg * 1024 * FF, TOK, DM, FF, FF};
                if (arg == 0) { E.base = ka.in(0); E.baseb = nullptr; }
                E.rss = (arg == 0) ? rss : (arg == 1 ? rss : (arg == 2 ? rss : nullptr));
                if (arg == 3) { E.xb = nullptr; E.out = outp; }
            } else if (arg == 4) { g = pg8::Gemm{Hb + Z0_MIX, (const bf16_t*)(ws + WS_WOUT0), TOK, DM, 768, LD0}; E.alpha = 1.0f; E.rss = rss; }
            else { g = pg8::Gemm{(const bf16_t*)(ws + WS_MIX1), (const bf16_t*)(ws + WS_WOUT1), TOK, DM, DM, DM}; E.alpha = 1.0f; E.rss = rss; }
            pg8::StaticOrder S; S.init(TOK, DM, C.G, (int)blockIdx.x);
            pg8::gemm_phase<pg8::EpiResid>(C.lds, C.tid, g, S, E); }
        } else if (kind == 3) { if (PHON(3)) { MKCTX();
            pg8::Gemm g; pg8::EpiScale E; pg8::StaticOrder S;
            if (arg == 0) { g = pg8::Gemm{xb, (const bf16_t*)(ws + WS_WIN0), TOK, LD0, DM, DM}; E = pg8::EpiScale{rss, Hb, LD0}; S.init(TOK, LD0, C.G, (int)blockIdx.x); }
            else { g = pg8::Gemm{xb, (const bf16_t*)(ws + WS_WIN1), TOK, LD1, DM, DM}; E = pg8::EpiScale{rss, Hb, LD1}; S.init(TOK, LD1, C.G, (int)blockIdx.x); }
            pg8::gemm_phase<pg8::EpiScale>(C.lds, C.tid, g, S, E); }
        } else if (kind == 4) { if (PHON(4)) { MKCTX(); phase_prep0(C, ka); } }
        else if (kind == 5) { if (PHON(5)) { MKCTX(); phase_att0(C, ka); } }
        else if (kind == 6) { if (PHON(6)) { MKCTX(); phase_comb0(C, ka); } }
        else if (kind == 7) { if (PHON(7)) { MKCTX(); phase_prep1(C, ka); } }
        else { if (PHON(8)) { MKCTX(); phase_att1(C, ka); } }
        }
        if (ph + 1 < a.ph_hi) { XcdBarrier xbar; xbar.bar = (unsigned*)(ws + WS_CTL); xbar.x = xb_xcc_id(); xbar.st = (volatile LAS unsigned*)((LAS unsigned char*)lds_raw + LDS_BAR_OFF); xcd_barrier(xbar); }
    }
}

#ifndef MULTI_LAUNCH
#define MULTI_LAUNCH 0
#endif

extern "C" void kernel_launch(void* const* d_in, const int* in_sizes, int n_in, void* d_out, int out_size, void* d_ws, size_t ws_size, hipStream_t stream) {
    static int grid = 0;
    if (grid == 0) {
        if (n_in != 31 || out_size != TOK * DM || ws_size < WS_END) { fprintf(stderr, "kernel_launch: unexpected shapes n_in %d out %d ws %zu\n", n_in, out_size, ws_size); grid = -1; return; }
        int dev = 0, cus = 0, per_cu = 0;
        (void)hipGetDevice(&dev); (void)hipDeviceGetAttribute(&cus, hipDeviceAttributeMultiprocessorCount, dev);
#if MULTI_LAUNCH
        const void* fns[9] = {(const void*)mega_fwd<1>, (const void*)mega_fwd<2>, (const void*)mega_fwd<4>, (const void*)mega_fwd<8>, (const void*)mega_fwd<16>, (const void*)mega_fwd<32>, (const void*)mega_fwd<64>, (const void*)mega_fwd<128>, (const void*)mega_fwd<256>};
        for (int i = 0; i < 9; ++i) if (hipFuncSetAttribute(fns[i], hipFuncAttributeMaxDynamicSharedMemorySize, LDS_BYTES) != hipSuccess) { fprintf(stderr, "kernel_launch: hipFuncSetAttribute failed\n"); grid = -1; return; }
        per_cu = 1;
#else
        if (hipFuncSetAttribute((const void*)mega_fwd<0x1ff>, hipFuncAttributeMaxDynamicSharedMemorySize, LDS_BYTES) != hipSuccess) { fprintf(stderr, "kernel_launch: hipFuncSetAttribute failed\n"); grid = -1; return; }
        if (hipOccupancyMaxActiveBlocksPerMultiprocessor(&per_cu, (const void*)mega_fwd<0x1ff>, 512, LDS_BYTES) != hipSuccess || per_cu < 1) { fprintf(stderr, "kernel_launch: occupancy query says %d\n", per_cu); per_cu = 1; }
#endif
        (void)hipGetLastError();
        grid = cus * 1;
    }
    if (grid < 0) return;
    Args a{};
    for (int i = 0; i < 31; ++i) a.in[i] = (const float*)d_in[i];
    a.out = (float*)d_out; a.ws = (unsigned char*)d_ws;
#if MULTI_LAUNCH
    static const int kinds[NPHASE] = {0, 1, 2, 3, 4, 5, 6, 2, 1, 2, 1, 2, 3, 7, 8, 2, 1, 2};
    for (int ph = 0; ph < NPHASE; ++ph) { a.ph_lo = ph; a.ph_hi = ph + 1;
        switch (kinds[ph]) {
            case 0: hipLaunchKernelGGL(mega_fwd<1>, dim3(grid), dim3(512), LDS_BYTES, stream, a); break;
            case 1: hipLaunchKernelGGL(mega_fwd<2>, dim3(grid), dim3(512), LDS_BYTES, stream, a); break;
            case 2: hipLaunchKernelGGL(mega_fwd<4>, dim3(grid), dim3(512), LDS_BYTES, stream, a); break;
            case 3: hipLaunchKernelGGL(mega_fwd<8>, dim3(grid), dim3(512), LDS_BYTES, stream, a); break;
            case 4: hipLaunchKernelGGL(mega_fwd<16>, dim3(grid), dim3(512), LDS_BYTES, stream, a); break;
            case 5: hipLaunchKernelGGL(mega_fwd<32>, dim3(grid), dim3(512), LDS_BYTES, stream, a); break;
            case 6: hipLaunchKernelGGL(mega_fwd<64>, dim3(grid), dim3(512), LDS_BYTES, stream, a); break;
            case 7: hipLaunchKernelGGL(mega_fwd<128>, dim3(grid), dim3(512), LDS_BYTES, stream, a); break;
            default: hipLaunchKernelGGL(mega_fwd<256>, dim3(grid), dim3(512), LDS_BYTES, stream, a); break;
        }
    }
#else
    a.ph_lo = 0; a.ph_hi = NPHASE;
    (void)hipMemsetAsync((char*)d_ws + WS_CTL, 0, 16384, stream);
    void* args[] = {&a};
    hipError_t e = hipLaunchCooperativeKernel((const void*)mega_fwd<0x1ff>, dim3(grid), dim3(512), args, LDS_BYTES, stream);
    if (e != hipSuccess) fprintf(stderr, "cooperative launch failed: %s (grid %d)\n", hipGetErrorString(e), grid);
#endif
}
```

```cpp
#include <hip/hip_runtime.h>
#include <hip/hip_cooperative_groups.h>
#include <cstdio>
#include <cstdint>
namespace cg = cooperative_groups;
#ifndef PROBE_SUB
#define PROBE_SUB 0
#endif

#define LAS __attribute__((address_space(3)))
#define DI __device__ __forceinline__
typedef unsigned short bf16_t;
typedef __attribute__((address_space(1))) unsigned short gbf16_t;
typedef short bf16x8 __attribute__((ext_vector_type(8)));
typedef short s16x4 __attribute__((ext_vector_type(4)));
typedef float f32x4 __attribute__((ext_vector_type(4)));
typedef float f32x16 __attribute__((ext_vector_type(16)));
typedef unsigned u32x4 __attribute__((ext_vector_type(4)));
typedef unsigned u32x2 __attribute__((ext_vector_type(2)));
typedef float f32x2_t __attribute__((ext_vector_type(2)));
typedef __bf16 bf16x2_t __attribute__((ext_vector_type(2)));

constexpr int BATCH = 16, SEQ = 2048, DM = 1024, FF = 2816, TOK = BATCH * SEQ;
constexpr int LD0 = 2816;
constexpr int LD1 = 2304;
constexpr int NIN0 = 2720, NIN1 = 2072;
constexpr int Z0_DIL = 416, Z0_MIX = 1952;
constexpr float EPS = 1e-6f, LOG2E = 1.4426950408889634f;
constexpr int T5RB = 2084;
constexpr int TABW = 2120;

constexpr size_t MiB = 1u << 20;
constexpr size_t WS_WGU = 0;
constexpr size_t WS_WDN = 44 * MiB;
constexpr size_t WS_WIN0 = 66 * MiB;
constexpr size_t WS_WOUT0 = WS_WIN0 + 5632 * 1024;
constexpr size_t WS_WIN1 = 73 * MiB;
constexpr size_t WS_WOUT1 = WS_WIN1 + 4608 * 1024;
constexpr size_t WS_WQB = 80 * MiB;
constexpr size_t WS_WKVB = WS_WQB + 512 * 1024;
constexpr size_t WS_WC1 = 81 * MiB;
constexpr size_t WS_WC2 = 82 * MiB;
constexpr size_t WS_SMALL = 84 * MiB;
constexpr size_t WS_RSS = 508 * MiB;
constexpr size_t WS_T5 = WS_SMALL + 1 * MiB;
constexpr size_t WS_ROPE = WS_SMALL + 2 * MiB;
constexpr size_t WS_CB = WS_SMALL + 3 * MiB;
constexpr size_t WS_KC = WS_SMALL + 4 * MiB;
constexpr size_t WS_VCT = WS_SMALL + 5 * MiB;
constexpr size_t WS_XB = 92 * MiB;
constexpr size_t WS_H = 156 * MiB;
constexpr size_t WS_A = 332 * MiB;
constexpr size_t WS_KM = WS_A;
constexpr size_t WS_VMT = WS_A + 48 * MiB;
constexpr size_t WS_VDT = WS_A + 80 * MiB;
constexpr size_t WS_QM = WS_A + 128 * MiB;
constexpr size_t OUT_OG = 0;
constexpr size_t OUT_LSE = 48 * MiB;
constexpr size_t WS_VT1 = WS_A;
constexpr size_t WS_MIX1 = WS_A + 32 * MiB;
constexpr size_t WS_END = 512 * MiB;

struct Args { const float* in[31]; float* out; unsigned char* ws; int ph_lo, ph_hi; };
typedef const __attribute__((address_space(4))) unsigned char* kptr_t;
struct KA {
    kptr_t k; unsigned char* ws; unsigned char* outb;
    __device__ __forceinline__ const float* in(int i) const { return *(const float* const __attribute__((address_space(4)))*)(k + 8 * i); }
};

DI unsigned cvtpk(float lo, float hi) { f32x2_t v = {lo, hi}; bf16x2_t b = __builtin_convertvector(v, bf16x2_t); return __builtin_bit_cast(unsigned, b); }
DI float bf2f(unsigned short u) { return __uint_as_float(((unsigned)u) << 16); }
DI float bflo(unsigned u) { return __uint_as_float(u << 16); }
DI float bfhi(unsigned u) { return __uint_as_float(u & 0xffff0000u); }
DI float fexp2(float x) { return __builtin_amdgcn_exp2f(x); }
DI float frcp(float x) { return __builtin_amdgcn_rcpf(x); }
DI int crow(int i, int h) { return (i & 3) + 8 * (i >> 2) + 4 * h; }
DI float max3f(float a, float b, float c) { float r; asm("v_max3_f32 %0, %1, %2, %3" : "=v"(r) : "v"(a), "v"(b), "v"(c)); return r; }
DI float max2f(float a, float b) { float r; asm("v_max_f32_e32 %0, %1, %2" : "=v"(r) : "v"(a), "v"(b)); return r; }
#define MFMA32(a, b, c) __builtin_amdgcn_mfma_f32_32x32x16_bf16((a), (b), (c), 0, 0, 0)

namespace pg8 {
constexpr int BM = 256, BK = 64, HALF = 128, HTB = HALF * BK * 2, STAGE_BYTES = 8 * HTB, NXCD = 8, WGM = 8;
DI int lds_byte(int r, int c) { const int st = (r >> 4) * 2 + (c >> 5), rr = r & 15, cc = c & 31, ob = rr * 64 + cc * 2; return st * 1024 + (ob ^ (((ob >> 9) & 1) << 5)); }
DI void stage_rc(int b, int& R, int& C) { const int st = b / 1024, sb = b % 1024, swz = sb ^ (((sb >> 9) & 1) << 5); R = (st >> 1) * 16 + swz / 64; C = (st & 1) * 32 + (swz % 64) / 2; }
DI int perm32(int rho) { const int n = rho >> 4, i = rho & 15; return 8 * (i >> 2) + 4 * n + (i & 3); }
struct Unit { int pm, pn; };
struct Gemm { const bf16_t* A; const bf16_t* Bt; int M, N, K, lda; };
struct StaticOrder {
    int nM, nN, nwg, G, c;
    DI void init(int M, int N, int G_, int c_) { nM = M / BM; nN = N / BM; nwg = nM * nN; G = G_; c = c_; }
    DI bool next(int i, Unit& u) const {
        const long L = (long)i * G + c; if (L >= nwg) return false;
        int wgid = (int)L; { const int q = nwg / NXCD, r = nwg % NXCD, xcd = wgid % NXCD, off = wgid / NXCD; wgid = (xcd < r ? xcd * (q + 1) : r * (q + 1) + (xcd - r) * q) + off; }
        const int nig = WGM * nN, gid = wgid / nig, fm = gid * WGM, gsz = (nM - fm) < WGM ? (nM - fm) : WGM;
        u.pm = fm + ((wgid % nig) % gsz); u.pn = (wgid % nig) / gsz; return true;
    }
};

DI float rss_sum(const float* rss, int row) {
    const f32x4* p = (const f32x4*)(rss + (size_t)row * 16); const f32x4 a = p[0], b = p[1], c = p[2], d = p[3];
    return (((a.x + a.y) + (a.z + a.w)) + ((b.x + b.y) + (b.z + b.w))) + (((c.x + c.y) + (c.z + c.w)) + ((d.x + d.y) + (d.z + d.w))); }
DI void row_rstd8(const float* rss, int row0, int lane, int fq, float (&rs)[8]) {
    float v[2];
#pragma unroll
    for (int e = 0; e < 2; ++e) { const int p = 2 * fq + e; const int row = row0 + (p >> 2) * 128 + (p & 3) * 16; v[e] = 1.0f / sqrtf(rss_sum(rss, row) * (1.0f / DM) + EPS); }
    const int fr = lane & 15;
#pragma unroll
    for (int q = 0; q < 4; ++q) { rs[2 * q] = __shfl(v[0], fr + 16 * q); rs[2 * q + 1] = __shfl(v[1], fr + 16 * q); }
}
struct EpiSwiglu {
    const float* rss; bf16_t* H;
    DI void operator()(const f32x4 (&acc)[2][2][4][2], const Unit& u, int wr, int wc, int fr, int fq) const {
        const int row0 = u.pm * BM + wr * 64 + fr, col = u.pn * 128 + wc * 32 + 8 * fq;
        float rs8[8]; row_rstd8(rss, row0, fr + 16 * fq, fq, rs8);
#pragma unroll
        for (int ai = 0; ai < 2; ++ai)
#pragma unroll
            for (int m = 0; m < 4; ++m) {
                const int row = row0 + ai * HALF + m * 16;
                const float rstd = rs8[ai * 4 + m];
                float hv[8];
#pragma unroll
                for (int n = 0; n < 2; ++n)
#pragma unroll
                    for (int j = 0; j < 4; j += 2) {
                        const float g0 = acc[ai][0][m][n][j] * rstd, u0 = acc[ai][1][m][n][j] * rstd, g1 = acc[ai][0][m][n][j + 1] * rstd, u1 = acc[ai][1][m][n][j + 1] * rstd;
                        const float d0 = 1.0f + fexp2(fminf(-g0 * LOG2E, 60.0f)), d1 = 1.0f + fexp2(fminf(-g1 * LOG2E, 60.0f));
                        const float rp = frcp(d0 * d1);
                        hv[4 * n + j] = g0 * (d1 * rp) * u0; hv[4 * n + j + 1] = g1 * (d0 * rp) * u1;
                    }
                u32x4 w; w.x = cvtpk(hv[0], hv[1]); w.y = cvtpk(hv[2], hv[3]); w.z = cvtpk(hv[4], hv[5]); w.w = cvtpk(hv[6], hv[7]);
                *(u32x4*)(H + (size_t)row * FF + col) = w;
            }
    }
};
struct EpiResid {
    const float* base; const bf16_t* baseb; float* out; bf16_t* xb; float* rss; float alpha;
    DI void operator()(const f32x4 (&acc)[2][2][4][2], const Unit& u, int wr, int wc, int fr, int fq) const {
        const int row0 = u.pm * BM + wr * 64 + fr, col0 = u.pn * BM + wc * 32 + 8 * fq;
        if (baseb) {
            u32x4 bw[2][4][2];
#pragma unroll
            for (int ai = 0; ai < 2; ++ai)
#pragma unroll
                for (int m = 0; m < 4; ++m)
#pragma unroll
                    for (int bj = 0; bj < 2; ++bj) bw[ai][m][bj] = *(const u32x4*)(baseb + (size_t)(row0 + ai * HALF + m * 16) * DM + col0 + bj * HALF);
#pragma unroll
            for (int ai = 0; ai < 2; ++ai)
#pragma unroll
                for (int m = 0; m < 4; ++m) {
                    const int row = row0 + ai * HALF + m * 16; float ss = 0.f;
#pragma unroll
                    for (int bj = 0; bj < 2; ++bj) {
                        const size_t off = (size_t)row * DM + col0 + bj * HALF; const u32x4 w = bw[ai][m][bj];
                        const f32x4 b0 = (f32x4){bflo(w.x), bfhi(w.x), bflo(w.y), bfhi(w.y)}, b1 = (f32x4){bflo(w.z), bfhi(w.z), bflo(w.w), bfhi(w.w)};
                        const f32x4 x0 = b0 + alpha * acc[ai][bj][m][0], x1 = b1 + alpha * acc[ai][bj][m][1];
                        if (out) { *(f32x4*)(out + off) = x0; *(f32x4*)(out + off + 4) = x1; }
                        if (xb) { u32x4 o; o.x = cvtpk(x0[0], x0[1]); o.y = cvtpk(x0[2], x0[3]); o.z = cvtpk(x1[0], x1[1]); o.w = cvtpk(x1[2], x1[3]); *(u32x4*)(xb + off) = o; }
                        ss += (x0[0] * x0[0] + x0[1] * x0[1]) + (x0[2] * x0[2] + x0[3] * x0[3]) + (x1[0] * x1[0] + x1[1] * x1[1]) + (x1[2] * x1[2] + x1[3] * x1[3]);
                    }
                    if (rss) { ss += __shfl_xor(ss, 16); ss += __shfl_xor(ss, 32); if (fq == 0) rss[(size_t)row * 16 + u.pn * 4 + wc] = ss; }
                }
            return;
        }
#pragma unroll
        for (int ai = 0; ai < 2; ++ai)
#pragma unroll
            for (int m = 0; m < 4; ++m) {
                const int row = row0 + ai * HALF + m * 16; float ss = 0.f;
#pragma unroll
                for (int bj = 0; bj < 2; ++bj) {
                    const size_t off = (size_t)row * DM + col0 + bj * HALF;
                    const f32x4 b0 = *(const f32x4*)(base + off), b1 = *(const f32x4*)(base + off + 4);
                    const f32x4 x0 = b0 + alpha * acc[ai][bj][m][0], x1 = b1 + alpha * acc[ai][bj][m][1];
                    if (out) { *(f32x4*)(out + off) = x0; *(f32x4*)(out + off + 4) = x1; }
                    if (xb) { u32x4 w; w.x = cvtpk(x0[0], x0[1]); w.y = cvtpk(x0[2], x0[3]); w.z = cvtpk(x1[0], x1[1]); w.w = cvtpk(x1[2], x1[3]); *(u32x4*)(xb + off) = w; }
                    ss += (x0[0] * x0[0] + x0[1] * x0[1]) + (x0[2] * x0[2] + x0[3] * x0[3]) + (x1[0] * x1[0] + x1[1] * x1[1]) + (x1[2] * x1[2] + x1[3] * x1[3]);
                }
                if (rss) { ss += __shfl_xor(ss, 16); ss += __shfl_xor(ss, 32); if (fq == 0) rss[(size_t)row * 16 + u.pn * 4 + wc] = ss; }
                asm volatile("" ::: "memory");
            }
    }
};
struct EpiScale {
    const float* rss; bf16_t* Z; int ldz;
    DI void operator()(const f32x4 (&acc)[2][2][4][2], const Unit& u, int wr, int wc, int fr, int fq) const {
        const int row0 = u.pm * BM + wr * 64 + fr, col0 = u.pn * BM + wc * 32 + 8 * fq;
        float rs8[8]; row_rstd8(rss, row0, fr + 16 * fq, fq, rs8);
#pragma unroll
        for (int ai = 0; ai < 2; ++ai)
#pragma unroll
            for (int m = 0; m < 4; ++m) {
                const int row = row0 + ai * HALF + m * 16;
                const float rstd = rs8[ai * 4 + m];
#pragma unroll
                for (int bj = 0; bj < 2; ++bj) {
                    const f32x4 v0 = acc[ai][bj][m][0] * rstd, v1 = acc[ai][bj][m][1] * rstd;
                    u32x4 w; w.x = cvtpk(v0[0], v0[1]); w.y = cvtpk(v0[2], v0[3]); w.z = cvtpk(v1[0], v1[1]); w.w = cvtpk(v1[2], v1[3]);
                    *(u32x4*)(Z + (size_t)row * ldz + col0 + bj * HALF) = w;
                }
            }
    }
};

template <class Epi>
DI void gemm_phase(LAS unsigned char* lds, const int tid, const Gemm g, const StaticOrder& S, const Epi& E) {
    const int wid = __builtin_amdgcn_readfirstlane(tid >> 6), lane = tid & 63, wr = wid >> 2, wc = wid & 3, fr = lane & 15, fq = lane >> 4;
    const int K = g.K, nt = K / BK, lda = g.lda;
    unsigned voffA[2], voffB[2];
#pragma unroll
    for (int i = 0; i < 2; ++i) { int R, C; stage_rc(tid * 16 + i * 8192, R, C); const int Rb = (R & ~31) + perm32(R & 31);
        voffA[i] = (unsigned)(R * lda + C) * 2u; voffB[i] = (unsigned)(Rb * K + C) * 2u; }
    const size_t kstep = (size_t)(BK * 2);
    const size_t hstepA = (size_t)HALF * lda * 2, hstepB = (size_t)HALF * K * 2;
    const size_t tstepA = 2 * hstepA, tstepB = 2 * hstepB;
    const unsigned ldsw = (unsigned)wid * 1024u;
    const int aoff = lds_byte(wr * 64 + fr, fq * 8), boff = lds_byte(wc * 32 + fr, fq * 8);
#define PG8_SA(b, h) (((b) * 2 + (h)) * HTB)
#define PG8_SB(b, h) ((4 + (b) * 2 + (h)) * HTB)
#define PG8_STAGE(bufoff, gbase, voff) do { _Pragma("unroll") for (int _i = 0; _i < 2; ++_i) \
        __builtin_amdgcn_global_load_lds((const unsigned*)((const char*)(gbase) + (voff)[_i]), (LAS unsigned*)(lds + (bufoff) + ldsw + _i * 8192), 16, 0, 0); } while (0)
#define PG8_LDA(dst, b, h) do { _Pragma("unroll") for (int m = 0; m < 4; ++m) _Pragma("unroll") for (int k = 0; k < 2; ++k) dst[m][k] = *(const LAS bf16x8*)(lds + PG8_SA(b, h) + aoff + m * 2048 + k * 1024); } while (0)
#define PG8_LDB(dst, b, h) do { _Pragma("unroll") for (int n = 0; n < 2; ++n) _Pragma("unroll") for (int k = 0; k < 2; ++k) dst[n][k] = *(const LAS bf16x8*)(lds + PG8_SB(b, h) + boff + n * 2048 + k * 1024); } while (0)
#define PG8_MMA(ai, bj, At, Bt) do { __builtin_amdgcn_s_setprio(1); _Pragma("unroll") for (int m = 0; m < 4; ++m) _Pragma("unroll") for (int n = 0; n < 2; ++n) _Pragma("unroll") for (int k = 0; k < 2; ++k) \
        acc[ai][bj][m][n] = __builtin_amdgcn_mfma_f32_16x16x32_bf16(Bt[n][k], At[m][k], acc[ai][bj][m][n], 0, 0, 0); __builtin_amdgcn_s_setprio(0); } while (0)
#define PG8_WAIT_V(n) asm volatile("s_waitcnt vmcnt(" #n ")" ::: "memory")
#define PG8_WAIT_L(n) asm volatile("s_waitcnt lgkmcnt(" #n ")" ::: "memory")
#define PG8_BAR __builtin_amdgcn_s_barrier()
#define PG8_SCHED __builtin_amdgcn_sched_barrier(0)
    Unit cur, nxt; int ui = 0;
    if (!S.next(0, cur)) return;
    f32x4 acc[2][2][4][2];
#pragma unroll
    for (int a = 0; a < 2; ++a)
#pragma unroll
        for (int b = 0; b < 2; ++b)
#pragma unroll
            for (int m = 0; m < 4; ++m)
#pragma unroll
                for (int n = 0; n < 2; ++n) acc[a][b][m][n] = (f32x4){0.f, 0.f, 0.f, 0.f};
    bf16x8 At[4][2], B0[2][2], B1[2][2];
    const char* cA = (const char*)g.A + (size_t)cur.pm * tstepA; const char* cB = (const char*)g.Bt + (size_t)cur.pn * tstepB;
    PG8_STAGE(PG8_SB(0, 0), cB, voffB); PG8_STAGE(PG8_SB(0, 1), cB + hstepB, voffB); PG8_STAGE(PG8_SA(0, 0), cA, voffA); PG8_STAGE(PG8_SA(0, 1), cA + hstepA, voffA);
    if (wr == 1) PG8_BAR;
    PG8_WAIT_V(2); PG8_BAR;
    PG8_STAGE(PG8_SB(1, 0), cB + kstep, voffB); PG8_STAGE(PG8_SA(1, 0), cA + kstep, voffA); PG8_STAGE(PG8_SB(1, 1), cB + hstepB + kstep, voffB);
    PG8_WAIT_V(6); PG8_BAR;
    for (;;) {
        const bool has_next = S.next(ui + 1, nxt);
        const char* nA = has_next ? (const char*)g.A + (size_t)nxt.pm * tstepA : cA; const char* nB = has_next ? (const char*)g.Bt + (size_t)nxt.pn * tstepB : cB;
        for (int t = 0; t < nt; t += 2) {
            const bool last = (t == nt - 2);
            const char* a1 = cA + (size_t)(t + 1) * kstep;
            const char* a2 = last ? nA : cA + (size_t)(t + 2) * kstep; const char* b2 = last ? nB : cB + (size_t)(t + 2) * kstep;
            const char* a3 = a2 + kstep; const char* b3 = b2 + kstep;
            PG8_LDB(B0, 0, 0); PG8_LDB(B1, 0, 1); PG8_SCHED; PG8_LDA(At, 0, 0); PG8_STAGE(PG8_SA(1, 1), a1 + hstepA, voffA);
            PG8_WAIT_V(8); PG8_WAIT_L(0); PG8_BAR; PG8_MMA(0, 0, At, B0); PG8_MMA(0, 1, At, B1); PG8_BAR; PG8_SCHED;
            PG8_LDA(At, 0, 1); PG8_STAGE(PG8_SB(0, 0), b2, voffB); PG8_STAGE(PG8_SB(0, 1), b2 + hstepB, voffB); PG8_STAGE(PG8_SA(0, 0), a2, voffA);
            PG8_WAIT_V(8); PG8_WAIT_L(0); PG8_BAR; PG8_MMA(1, 0, At, B0); PG8_MMA(1, 1, At, B1); PG8_BAR; PG8_SCHED;
            PG8_LDB(B0, 1, 0); PG8_LDB(B1, 1, 1); PG8_SCHED; PG8_LDA(At, 1, 0); PG8_STAGE(PG8_SA(0, 1), a2 + hstepA, voffA);
            PG8_WAIT_V(8); PG8_WAIT_L(0); PG8_BAR; PG8_MMA(0, 0, At, B0); PG8_MMA(0, 1, At, B1); PG8_BAR; PG8_SCHED;
            PG8_LDA(At, 1, 1); PG8_STAGE(PG8_SB(1, 0), b3, voffB); PG8_STAGE(PG8_SB(1, 1), b3 + hstepB, voffB); PG8_STAGE(PG8_SA(1, 0), a3, voffA);
            PG8_WAIT_V(8); PG8_WAIT_L(0); PG8_BAR; PG8_MMA(1, 0, At, B0); PG8_MMA(1, 1, At, B1); PG8_BAR; PG8_SCHED;
        }
        if (wr == 0) PG8_BAR;
        E(acc, cur, wr, wc, fr, fq);
        if (!has_next) break;
#pragma unroll
        for (int a = 0; a < 2; ++a)
#pragma unroll
            for (int b = 0; b < 2; ++b)
#pragma unroll
                for (int m = 0; m < 4; ++m)
#pragma unroll
                    for (int n = 0; n < 2; ++n) acc[a][b][m][n] = (f32x4){0.f, 0.f, 0.f, 0.f};
        cur = nxt; cA = nA; cB = nB; ++ui;
        if (wr == 1) PG8_BAR;
    }
    PG8_WAIT_V(0);
    PG8_BAR;
#undef PG8_SA
#undef PG8_SB
#undef PG8_STAGE
#undef PG8_LDA
#undef PG8_LDB
#undef PG8_MMA
}
}

struct Ctx {
    LAS unsigned char* lds;
    int tid, lane, wave, n, h;
    int gw, NGW, G;
};

DI int t5_bucket(int n) {
    if (n < 16) return n;
    const int v = 16 + (int)(__builtin_amdgcn_logf((float)n * 0.0625f) * (16.0f / 7.0f));
    return v < 31 ? v : 31;
}

DI void transpose_item(const float* __restrict__ W, int K, int N, bf16_t* WT, int ldw, int row_base, const float* __restrict__ gain, LAS float* scr, int item, int lane) {
    const int nblk = (N + 31) / 32, kb = item / nblk, nb = item % nblk, k0 = 64 * kb, n0 = 32 * nb;
    float tv[32];
#pragma unroll
    for (int i = 0; i < 32; ++i) { const int kk = 2 * i + (lane >> 5), nn = n0 + (lane & 31); tv[i] = (nn < N) ? W[(size_t)(k0 + kk) * N + nn] : 0.f; }
#pragma unroll
    for (int i = 0; i < 32; ++i) { const int kk = 2 * i + (lane >> 5); float v = tv[i]; if (gain) v *= gain[k0 + kk]; scr[kk * 33 + (lane & 31)] = v; }
    asm volatile("s_waitcnt lgkmcnt(0)" ::: "memory");
    const int c = lane & 7;
#pragma unroll
    for (int j = 0; j < 4; ++j) { const int nl = (lane >> 3) + 8 * j; const LAS float* s = scr + (8 * c) * 33 + nl;
        u32x4 o; o.x = cvtpk(s[0 * 33], s[1 * 33]); o.y = cvtpk(s[2 * 33], s[3 * 33]); o.z = cvtpk(s[4 * 33], s[5 * 33]); o.w = cvtpk(s[6 * 33], s[7 * 33]);
        *(u32x4*)(WT + (size_t)(row_base + nl) * ldw + k0 + 8 * c) = o; }
    asm volatile("s_waitcnt lgkmcnt(0)" ::: "memory");
}

DI void phase_prologue(const Ctx& C, const KA& a) {
    unsigned char* ws = a.ws;
    LAS float* scr = (LAS float*)(C.lds + C.wave * 8704);
    const int I_GU = 16 * 88, I_DN = 44 * 32, I_IN0 = 16 * 85, I_OUT0 = 12 * 32, I_IN1 = 16 * 65, I_OUT1 = 16 * 32, I_QB = 4 * 24, I_KVB = 2 * 32, I_C1 = 32 * 4, I_C2 = 2 * 2;
    const int NIT = 8 * I_GU + 4 * I_DN + I_IN0 + I_OUT0 + I_IN1 + I_OUT1 + I_QB + I_KVB + 2 * I_C1 + 2 * I_C2;
    for (int prep_ = 0; prep_ < ((PROBE_SUB == 6) ? 2 : 1); ++prep_)
    for (int it = C.gw; it < NIT; it += C.NGW) {
        int r = it;
        if (r < 8 * I_GU) {
            const int mat = r / I_GU, item = r % I_GU, l = mat >> 2, f = (mat >> 1) & 1, up = mat & 1;
            const float* W = a.in(f ? (up ? 9 : 8) : (up ? 4 : 3)) + (size_t)l * DM * FF;
            const float* gn = a.in(f ? 7 : 2) + l * DM;
            const int nb = item % 88, n0 = 32 * nb;
            bf16_t* WT = (bf16_t*)(ws + WS_WGU) + (size_t)(l * 2 + f) * 5632 * 1024;
            transpose_item(W, DM, FF, WT, DM, (n0 >> 7) * 256 + up * 128 + (n0 & 127), gn, scr, item, C.lane);
            continue;
        }
        r -= 8 * I_GU;
        if (r < 4 * I_DN) { const int mat = r / I_DN, item = r % I_DN, l = mat >> 1, f = mat & 1;
            const float* W = a.in(f ? 10 : 5) + (size_t)l * FF * DM;
            bf16_t* WT = (bf16_t*)(ws + WS_WDN) + (size_t)(l * 2 + f) * 1024 * FF;
            transpose_item(W, FF, DM, WT, FF, 32 * (item % 32), nullptr, scr, item, C.lane); continue; }
        r -= 4 * I_DN;
        if (r < I_IN0) { transpose_item(a.in(11), DM, NIN0, (bf16_t*)(ws + WS_WIN0), DM, 32 * (r % 85), a.in(6), scr, r, C.lane); continue; }
        r -= I_IN0;
        if (r < I_OUT0) { transpose_item(a.in(20), 768, DM, (bf16_t*)(ws + WS_WOUT0), 768, 32 * (r % 32), nullptr, scr, r, C.lane); continue; }
        r -= I_OUT0;
        if (r < I_IN1) { transpose_item(a.in(21), DM, NIN1, (bf16_t*)(ws + WS_WIN1), DM, 32 * (r % 65), a.in(6) + DM, scr, r, C.lane); continue; }
        r -= I_IN1;
        if (r < I_OUT1) { transpose_item(a.in(30), DM, DM, (bf16_t*)(ws + WS_WOUT1), DM, 32 * (r % 32), nullptr, scr, r, C.lane); continue; }
        r -= I_OUT1;
        if (r < I_QB) { transpose_item(a.in(13), 256, 768, (bf16_t*)(ws + WS_WQB), 256, 32 * (r % 24), a.in(12), scr, r, C.lane); continue; }
        r -= I_QB;
        if (r < I_KVB) { transpose_item(a.in(15), 128, 1024, (bf16_t*)(ws + WS_WKVB), 128, 32 * (r % 32), a.in(14), scr, r, C.lane); continue; }
        r -= I_KVB;
        if (r < 2 * I_C1) { const int w = r / I_C1, item = r % I_C1;
            transpose_item(a.in(28) + (size_t)w * 2048 * 128, 2048, 128, (bf16_t*)(ws + WS_WC1) + (size_t)w * 128 * 2048, 2048, 32 * (item % 4), nullptr, scr, item, C.lane); continue; }
        r -= 2 * I_C1;
        { const int w = r / I_C2, item = r % I_C2;
            transpose_item(a.in(29) + (size_t)w * 128 * 64, 128, 64, (bf16_t*)(ws + WS_WC2) + (size_t)w * 64 * 128, 128, 32 * (item % 2), nullptr, scr, item, C.lane); }
    }
    {
        const float* x = a.in(0); bf16_t* xb = (bf16_t*)(ws + WS_XB); float* rss = (float*)(ws + WS_RSS);
        for (int prep_ = 0; prep_ < ((PROBE_SUB == 7) ? 2 : 1); ++prep_)
        for (int m0 = 2 * C.gw; m0 < TOK; m0 += 2 * C.NGW) {
            f32x4 v[2][4];
#pragma unroll
            for (int rr = 0; rr < 2; ++rr) { const f32x4* xr = (const f32x4*)(x + (size_t)(m0 + rr) * DM) + C.lane;
#pragma unroll
                for (int j = 0; j < 4; ++j) v[rr][j] = xr[64 * j]; }
#pragma unroll
            for (int rr = 0; rr < 2; ++rr) { const int m = m0 + rr; float s = 0.f;
                unsigned long long* o8 = (unsigned long long*)(xb + (size_t)m * DM) + C.lane;
#pragma unroll
                for (int j = 0; j < 4; ++j) { const f32x4 w = v[rr][j]; s += (w.x * w.x + w.y * w.y) + (w.z * w.z + w.w * w.w);
                    o8[64 * j] = (unsigned long long)cvtpk(w.x, w.y) | ((unsigned long long)cvtpk(w.z, w.w) << 32); }
#pragma unroll
                for (int o = 1; o < 64; o <<= 1) s += __shfl_xor(s, o);
                if (C.lane < 16) rss[(size_t)m * 16 + C.lane] = (C.lane == 0) ? s : 0.f; }
        }
        const int gt = C.gw * 64 + C.lane, NT = C.NGW * 64;
        float* t5 = (float*)(ws + WS_T5); const float* rb = a.in(1);
        for (int i = gt; i < 16 * TABW; i += NT) { const int col = i / TABW, d = T5RB - i % TABW; float v = 0.f; if (d >= 0 && d <= 2048) v = rb[t5_bucket(d) * 16 + col] * LOG2E; t5[i] = v; }
        float* rope = (float*)(ws + WS_ROPE);
        for (int i = gt; i < 2048 * 16; i += NT) { const int t = i >> 4, f = i & 15; const float inv = fexp2(-(float)f * (13.287712379549449f / 16.0f)); const float ang = (float)t * inv;
            const double rev = (double)ang * 0.15915494309189535; const float fr = (float)(rev - __builtin_rint(rev));
            rope[2 * i] = __builtin_amdgcn_cosf(fr); rope[2 * i + 1] = __builtin_amdgcn_sinf(fr); }
        float* cb = (float*)(ws + WS_CB);
        for (int o = C.gw; o < 256; o += C.NGW) { const int w = o >> 7, j = o & 127; const float* pos = a.in(27) + w * 2048; const float* w1 = a.in(28) + (size_t)w * 2048 * 128; float sacc = 0.f;
#pragma unroll 8
            for (int k = C.lane; k < 2048; k += 64) sacc += pos[k] * w1[(size_t)k * 128 + j];
#pragma unroll
            for (int off = 1; off < 64; off <<= 1) sacc += __shfl_xor(sacc, off);
            if (C.lane == 0) cb[o] = sacc; }
    }
}

template <int DK, int DSC, bool BIAS, bool SEL, bool LOCK = false>
DI void attn_tiles(f32x16& o0, f32x16& o1, float& m, float& l, const bf16x8 (&qf)[DK / 16], const char* kl, size_t kstride, const char* vl, size_t vstride,
                   int kt_lo, int kt_hi, int tq, int W, const LAS float* tab, unsigned selw, int h, int blk_lo = 0, int blk_hi = 0) {
    if (LOCK) { for (int kt = blk_lo; kt < kt_lo; ++kt) __builtin_amdgcn_s_barrier(); }
    bf16x8 kf[DK / 16]; s16x4 va[8];
    {
        const char* kp = kl + (size_t)(32 * kt_lo) * kstride;
#pragma unroll
        for (int ks = 0; ks < DK / 16; ++ks) kf[ks] = *(const bf16x8*)(kp + ks * 32);
        const char* vp = vl + (size_t)(32 * kt_lo) * 2; const char* vp2 = vp + 32 * vstride;
#pragma unroll
        for (int j = 0; j < 4; ++j) { va[j] = *(const s16x4*)(vp + 16 * j); va[4 + j] = *(const s16x4*)(vp2 + 16 * j); }
    }
#pragma unroll 1
    for (int kt = kt_lo; kt <= kt_hi; ++kt) {
        const int k0 = 32 * kt;
        if (LOCK) __builtin_amdgcn_s_barrier();
        f32x16 s;
#pragma unroll
        for (int i = 0; i < 16; ++i) s[i] = 0.f;
#pragma unroll
        for (int ks = 0; ks < DK / 16; ++ks) s = MFMA32(kf[ks], qf[ks], s);
        __builtin_amdgcn_sched_barrier(0);
        s16x4 vb[8];
        {
            const int ktn = (kt < kt_hi) ? kt + 1 : kt_hi;
            const char* kp = kl + (size_t)(32 * ktn) * kstride;
#pragma unroll
            for (int ks = 0; ks < DK / 16; ++ks) kf[ks] = *(const bf16x8*)(kp + ks * 32);
            const char* vp = vl + (size_t)(32 * ktn) * 2; const char* vp2 = vp + 32 * vstride;
#pragma unroll
            for (int j = 0; j < 4; ++j) { vb[j] = *(const s16x4*)(vp + 16 * j); vb[4 + j] = *(const s16x4*)(vp2 + 16 * j); }
        }
        asm volatile("" ::: "memory");
        __builtin_amdgcn_sched_barrier(0);
        const int dbase = tq - k0 - 4 * h;
        const bool selok = SEL ? (((selw >> (kt >> 1)) & 1u) != 0u) : true;
        const LAS float* tb = tab + (dbase - 27) * DSC;
        float mx = -INFINITY;
#pragma unroll
        for (int i = 0; i < 16; ++i) {
            const int c = (i & 3) + 8 * (i >> 2); const int delta = dbase - c;
            float v = s[i]; if (BIAS) v += tb[(27 - c) * DSC];
            v = ((unsigned)delta < (unsigned)W && selok) ? v : -INFINITY; s[i] = v; mx = fmaxf(mx, v);
        }
        mx = fmaxf(mx, __shfl_xor(mx, 32));
        const float mn = fmaxf(m, mx), mu = (mn == -INFINITY) ? 0.f : mn;
        const float alpha = fexp2(m - mu); m = mn;
        float rs = 0.f;
#pragma unroll
        for (int i = 0; i < 16; ++i) { s[i] = fexp2(s[i] - mu); rs += s[i]; }
        l = l * alpha + rs;
#pragma unroll
        for (int i = 0; i < 16; ++i) { o0[i] *= alpha; o1[i] *= alpha; }
        u32x4 p0, p1;
        p0.x = cvtpk(s[0], s[1]); p0.y = cvtpk(s[2], s[3]); p0.z = cvtpk(s[4], s[5]); p0.w = cvtpk(s[6], s[7]);
        p1.x = cvtpk(s[8], s[9]); p1.y = cvtpk(s[10], s[11]); p1.z = cvtpk(s[12], s[13]); p1.w = cvtpk(s[14], s[15]);
        const bf16x8 pb0 = __builtin_bit_cast(bf16x8, p0), pb1 = __builtin_bit_cast(bf16x8, p1);
        o0 = MFMA32(__builtin_shufflevector(va[0], va[1], 0, 1, 2, 3, 4, 5, 6, 7), pb0, o0);
        o0 = MFMA32(__builtin_shufflevector(va[2], va[3], 0, 1, 2, 3, 4, 5, 6, 7), pb1, o0);
        o1 = MFMA32(__builtin_shufflevector(va[4], va[5], 0, 1, 2, 3, 4, 5, 6, 7), pb0, o1);
        o1 = MFMA32(__builtin_shufflevector(va[6], va[7], 0, 1, 2, 3, 4, 5, 6, 7), pb1, o1);
        __builtin_amdgcn_sched_barrier(0);
#pragma unroll
        for (int j = 0; j < 8; ++j) va[j] = vb[j];
    }
    if (LOCK) { for (int kt = kt_hi + 1; kt <= blk_hi; ++kt) __builtin_amdgcn_s_barrier(); }
}

DI void load_q64(bf16x8 (&qf)[4], const bf16_t* qrow, const float* __restrict__ gain, float scale, int h) {
    u32x4 raw[4]; float ss = 0.f;
#pragma unroll
    for (int ks = 0; ks < 4; ++ks) { raw[ks] = *(const u32x4*)(qrow + 16 * ks + 8 * h);
#pragma unroll
        for (int j = 0; j < 4; ++j) { const float a = bflo(raw[ks][j]), b = bfhi(raw[ks][j]); ss += a * a + b * b; } }
    ss += __shfl_xor(ss, 32);
    const float r = scale / sqrtf(ss * (1.0f / 64.0f) + EPS);
#pragma unroll
    for (int ks = 0; ks < 4; ++ks) { u32x4 w; const f32x4 g0 = *(const f32x4*)(gain + 16 * ks + 8 * h), g1 = *(const f32x4*)(gain + 16 * ks + 8 * h + 4);
        w.x = cvtpk(bflo(raw[ks].x) * r * g0.x, bfhi(raw[ks].x) * r * g0.y); w.y = cvtpk(bflo(raw[ks].y) * r * g0.z, bfhi(raw[ks].y) * r * g0.w);
        w.z = cvtpk(bflo(raw[ks].z) * r * g1.x, bfhi(raw[ks].z) * r * g1.y); w.w = cvtpk(bflo(raw[ks].w) * r * g1.z, bfhi(raw[ks].w) * r * g1.w);
        qf[ks] = __builtin_bit_cast(bf16x8, w); }
}

DI void zero16(f32x16& v) {
#pragma unroll
    for (int i = 0; i < 16; ++i) v[i] = 0.f;
}
DI void store_o64(bf16_t* dst, const f32x16& o0, const f32x16& o1, float sc, int h) {
#pragma unroll
    for (int q = 0; q < 4; ++q) {
        u32x2 w; w.x = cvtpk(o0[4 * q] * sc, o0[4 * q + 1] * sc); w.y = cvtpk(o0[4 * q + 2] * sc, o0[4 * q + 3] * sc);
        *(u32x2*)(dst + 8 * q + 4 * h) = w;
        u32x2 w2; w2.x = cvtpk(o1[4 * q] * sc, o1[4 * q + 1] * sc); w2.y = cvtpk(o1[4 * q + 2] * sc, o1[4 * q + 3] * sc);
        *(u32x2*)(dst + 32 + 8 * q + 4 * h) = w2;
    }
}

DI int deal(int it, int gw, int NGW, int total) {
    int pos = gw; if (it & 1) pos = NGW - 1 - gw;
    const long e = (long)it * NGW + pos; return e < total ? (int)e : -1;
}

DI void mla_prep_item(const Ctx& C, const KA& a, int item) {
    unsigned char* ws = a.ws;
    int ln_ = C.lane; asm volatile("" : "+v"(ln_));
    const int tt = item >> 2, part = item & 3, n = ln_ & 31, h = ln_ >> 5;
    const int tok = tt * 32 + n, b = tok >> 11, t = tok & 2047;
    const bf16_t* zr = (const bf16_t*)(ws + WS_H) + (size_t)tok * LD0;
    const bf16_t* Wqb = (const bf16_t*)(ws + WS_WQB); const bf16_t* Wkvb = (const bf16_t*)(ws + WS_WKVB);
    const float* rope = (const float*)(ws + WS_ROPE) + (size_t)t * 32;
    bf16x8 cq[16];
    {
        u32x4 raw[16]; float ss = 0.f;
#pragma unroll
        for (int ks = 0; ks < 16; ++ks) { raw[ks] = *(const u32x4*)(zr + 16 * ks + 8 * h);
#pragma unroll
            for (int j = 0; j < 4; ++j) { const float x = bflo(raw[ks][j]), y = bfhi(raw[ks][j]); ss += x * x + y * y; } }
        ss += __shfl_xor(ss, 32);
        const float r = 1.0f / sqrtf(ss * (1.0f / 256.0f) + EPS);
#pragma unroll
        for (int ks = 0; ks < 16; ++ks) { u32x4 w;
#pragma unroll
            for (int j = 0; j < 4; ++j) w[j] = cvtpk(bflo(raw[ks][j]) * r, bfhi(raw[ks][j]) * r);
            cq[ks] = __builtin_bit_cast(bf16x8, w); }
    }
    const float* qg = a.in(16); const float* kg = a.in(17);
    bf16_t* qm = (bf16_t*)(ws + WS_QM); bf16_t* km = (bf16_t*)(ws + WS_KM); bf16_t* vmT = (bf16_t*)(ws + WS_VMT);
    const float qscale = 0.10206207261596575f * LOG2E;
#pragma unroll 1
    for (int hh = 0; hh < 2; ++hh) {
        const int head = part * 2 + hh;
        f32x16 acc3[3];
#pragma unroll
        for (int ft = 0; ft < 3; ++ft) { zero16(acc3[ft]); const bf16_t* wr = Wqb + (size_t)(head * 96 + 32 * ft + n) * 256 + 8 * h;
#pragma unroll
            for (int k8 = 0; k8 < 16; k8 += 8) { bf16x8 wa[8];
#pragma unroll
                for (int j = 0; j < 8; ++j) wa[j] = *(const bf16x8*)(wr + 16 * (k8 + j));
#pragma unroll
                for (int j = 0; j < 8; ++j) acc3[ft] = MFMA32(wa[j], cq[k8 + j], acc3[ft]);
                asm volatile("" ::: "memory"); } }
        float ss = 0.f;
#pragma unroll
        for (int ft = 0; ft < 3; ++ft)
#pragma unroll
            for (int i = 0; i < 16; ++i) ss += acc3[ft][i] * acc3[ft][i];
        ss += __shfl_xor(ss, 32);
        const float r = qscale / sqrtf(ss * (1.0f / 96.0f) + EPS);
        bf16_t* dst = qm + ((size_t)(b * 8 + head) * SEQ + t) * 96;
#pragma unroll
        for (int ft = 0; ft < 2; ++ft)
#pragma unroll
            for (int q = 0; q < 4; ++q) { const int f = 32 * ft + 8 * q + 4 * h; const f32x4 g = *(const f32x4*)(qg + f);
                u32x2 w; w.x = cvtpk(acc3[ft][4 * q] * r * g.x, acc3[ft][4 * q + 1] * r * g.y); w.y = cvtpk(acc3[ft][4 * q + 2] * r * g.z, acc3[ft][4 * q + 3] * r * g.w);
                *(u32x2*)(dst + f) = w; }
#pragma unroll
        for (int q = 0; q < 2; ++q) { const int f1 = 8 * q + 4 * h; const f32x4 g1 = *(const f32x4*)(qg + 64 + f1), g2 = *(const f32x4*)(qg + 80 + f1);
            float o1[4], o2[4];
#pragma unroll
            for (int j = 0; j < 4; ++j) { const float x1 = acc3[2][4 * q + j] * r * g1[j], x2 = acc3[2][4 * q + 8 + j] * r * g2[j]; const float cs = rope[2 * (f1 + j)], sn = rope[2 * (f1 + j) + 1];
                o1[j] = x1 * cs - x2 * sn; o2[j] = x2 * cs + x1 * sn; }
            u32x2 w; w.x = cvtpk(o1[0], o1[1]); w.y = cvtpk(o1[2], o1[3]); *(u32x2*)(dst + 64 + f1) = w;
            u32x2 w2; w2.x = cvtpk(o2[0], o2[1]); w2.y = cvtpk(o2[2], o2[3]); *(u32x2*)(dst + 80 + f1) = w2; }
    }
    asm volatile("" ::: "memory");
    bf16x8 ckv[8];
    {
        u32x4 raw[8]; float ss = 0.f;
#pragma unroll
        for (int ks = 0; ks < 8; ++ks) { raw[ks] = *(const u32x4*)(zr + 256 + 16 * ks + 8 * h);
#pragma unroll
            for (int j = 0; j < 4; ++j) { const float x = bflo(raw[ks][j]), y = bfhi(raw[ks][j]); ss += x * x + y * y; } }
        ss += __shfl_xor(ss, 32);
        const float r = 1.0f / sqrtf(ss * (1.0f / 128.0f) + EPS);
#pragma unroll
        for (int ks = 0; ks < 8; ++ks) { u32x4 w;
#pragma unroll
            for (int j = 0; j < 4; ++j) w[j] = cvtpk(bflo(raw[ks][j]) * r, bfhi(raw[ks][j]) * r);
            ckv[ks] = __builtin_bit_cast(bf16x8, w); }
    }
    float kr1[8], kr2[8]; float ssr = 0.f;
#pragma unroll
    for (int q = 0; q < 2; ++q) { const u32x2 r1 = *(const u32x2*)(zr + 384 + 8 * q + 4 * h), r2 = *(const u32x2*)(zr + 400 + 8 * q + 4 * h);
        kr1[4 * q] = bflo(r1.x); kr1[4 * q + 1] = bfhi(r1.x); kr1[4 * q + 2] = bflo(r1.y); kr1[4 * q + 3] = bfhi(r1.y);
        kr2[4 * q] = bflo(r2.x); kr2[4 * q + 1] = bfhi(r2.x); kr2[4 * q + 2] = bflo(r2.y); kr2[4 * q + 3] = bfhi(r2.y); }
#pragma unroll
    for (int j = 0; j < 8; ++j) ssr += kr1[j] * kr1[j] + kr2[j] * kr2[j];
    ssr += __shfl_xor(ssr, 32);
#pragma unroll 1
    for (int hh = 0; hh < 2; ++hh) {
        const int head = part * 2 + hh;
        float ss = 0.f;
#pragma unroll 1
        for (int ft = 0; ft < 2; ++ft) { f32x16 acc; zero16(acc); const bf16_t* wr = Wkvb + (size_t)(head * 128 + 32 * ft + n) * 128 + 8 * h;
#pragma unroll
            for (int ks = 0; ks < 8; ++ks) { const bf16x8 wa = *(const bf16x8*)(wr + 16 * ks); acc = MFMA32(wa, ckv[ks], acc); }
#pragma unroll
            for (int i = 0; i < 16; ++i) ss += acc[i] * acc[i]; }
        ss += __shfl_xor(ss, 32);
        const float r = 1.0f / sqrtf((ss + ssr) * (1.0f / 96.0f) + EPS);
        bf16_t* dst = km + ((size_t)(b * 8 + head) * SEQ + t) * 96;
        bf16_t* vd = vmT + ((size_t)(b * 8 + head) * 64 + 4 * h) * SEQ + t;
#pragma unroll 1
        for (int ft = 0; ft < 4; ++ft) { f32x16 acc; zero16(acc); const bf16_t* wr = Wkvb + (size_t)(head * 128 + 32 * ft + n) * 128 + 8 * h;
#pragma unroll
            for (int ks = 0; ks < 8; ++ks) { const bf16x8 wa = *(const bf16x8*)(wr + 16 * ks); acc = MFMA32(wa, ckv[ks], acc); }
            if (ft < 2) {
#pragma unroll
                for (int q = 0; q < 4; ++q) { const int f = 32 * ft + 8 * q + 4 * h; const f32x4 g = *(const f32x4*)(kg + f);
                    u32x2 w; w.x = cvtpk(acc[4 * q] * r * g.x, acc[4 * q + 1] * r * g.y); w.y = cvtpk(acc[4 * q + 2] * r * g.z, acc[4 * q + 3] * r * g.w);
                    *(u32x2*)(dst + f) = w; }
            } else {
                bf16_t* vp_ = vd + (size_t)(32 * (ft - 2)) * SEQ; asm volatile("" : "+v"(vp_)); gbf16_t* vp = (gbf16_t*)vp_;
#pragma unroll
                for (int i = 0; i < 16; ++i) vp[(size_t)crow(i, 0) * SEQ] = (bf16_t)(cvtpk(acc[i], 0.f) & 0xffffu);
            }
        }
#pragma unroll
        for (int q = 0; q < 2; ++q) { const int f1 = 8 * q + 4 * h; const f32x4 g1 = *(const f32x4*)(kg + 64 + f1), g2 = *(const f32x4*)(kg + 80 + f1);
            float o1[4], o2[4];
#pragma unroll
            for (int j = 0; j < 4; ++j) { const float x1 = kr1[4 * q + j] * r * g1[j], x2 = kr2[4 * q + j] * r * g2[j]; const float cs = rope[2 * (f1 + j)], sn = rope[2 * (f1 + j) + 1];
                o1[j] = x1 * cs - x2 * sn; o2[j] = x2 * cs + x1 * sn; }
            u32x2 w; w.x = cvtpk(o1[0], o1[1]); w.y = cvtpk(o1[2], o1[3]); *(u32x2*)(dst + 64 + f1) = w;
            u32x2 w2; w2.x = cvtpk(o2[0], o2[1]); w2.y = cvtpk(o2[2], o2[3]); *(u32x2*)(dst + 80 + f1) = w2; }
    }
}

DI void norm_heads_inplace(const Ctx& C, bf16_t* z, int ld, int col0, int nheads, const float* __restrict__ gain) {
    const int sub = C.lane & 7; const long nchunks = (long)TOK * nheads;
    f32x4 g0 = *(const f32x4*)(gain + 8 * sub), g1 = *(const f32x4*)(gain + 8 * sub + 4);
    for (long c0 = (long)C.gw * 32 + (C.lane >> 3); c0 < nchunks; c0 += (long)C.NGW * 32) {
        u32x4 raw[4]; bf16_t* pp[4];
#pragma unroll
        for (int u = 0; u < 4; ++u) { const long c = c0 + 8 * u; const bool ok = c < nchunks; const long cc = ok ? c : 0;
            const int tok = (int)(cc / nheads), hd = (int)(cc % nheads);
            pp[u] = ok ? z + (size_t)tok * ld + col0 + hd * 64 + 8 * sub : nullptr;
            raw[u] = ok ? *(const u32x4*)pp[u] : (u32x4){0u, 0u, 0u, 0u}; }
#pragma unroll
        for (int u = 0; u < 4; ++u) {
            float v[8]; float ss = 0.f;
#pragma unroll
            for (int j = 0; j < 4; ++j) { v[2 * j] = bflo(raw[u][j]); v[2 * j + 1] = bfhi(raw[u][j]); ss += v[2 * j] * v[2 * j] + v[2 * j + 1] * v[2 * j + 1]; }
            ss += __shfl_xor(ss, 1); ss += __shfl_xor(ss, 2); ss += __shfl_xor(ss, 4);
            const float r = 1.0f / sqrtf(ss * (1.0f / 64.0f) + EPS);
            u32x4 w; w.x = cvtpk(v[0] * r * g0.x, v[1] * r * g0.y); w.y = cvtpk(v[2] * r * g0.z, v[3] * r * g0.w); w.z = cvtpk(v[4] * r * g1.x, v[5] * r * g1.y); w.w = cvtpk(v[6] * r * g1.z, v[7] * r * g1.w);
            if (pp[u]) *(u32x4*)pp[u] = w;
        }
    }
}
DI void vt_scatter(const Ctx& C, const bf16_t* z, int ld, int col0, int nheads, int hd_lo, int hd_n, int d, bf16_t* vT) {
    const long nitems = (long)(TOK / 64) * hd_n;
    for (long it = C.gw; it < nitems; it += C.NGW) {
        const int tile = (int)(it / hd_n), hd = hd_lo + (int)(it % hd_n);
        const int tok = tile * 64 + C.lane, b = tok >> 11, t = tok & 2047;
        const int pos = (t % d) * (SEQ / d) + t / d;
        const bf16_t* p = z + (size_t)tok * ld + col0 + hd * 64;
        bf16_t* o_ = vT + ((size_t)(b * nheads + hd) * 64) * SEQ + pos; asm volatile("" : "+v"(o_)); gbf16_t* o = (gbf16_t*)o_;
#pragma unroll
        for (int c8 = 0; c8 < 8; ++c8) { const u32x4 raw = *(const u32x4*)(p + 8 * c8);
#pragma unroll
            for (int j = 0; j < 4; ++j) { o[(size_t)(8 * c8 + 2 * j) * SEQ] = (bf16_t)(raw[j] & 0xffffu); o[(size_t)(8 * c8 + 2 * j + 1) * SEQ] = (bf16_t)(raw[j] >> 16); } }
    }
}

DI void phase_prep0(const Ctx& C, const KA& a) {
    unsigned char* ws = a.ws; bf16_t* z = (bf16_t*)(ws + WS_H);
    for (int it = C.gw; it < 4096; it += C.NGW) mla_prep_item(C, a, it);
    bf16_t* vdT = (bf16_t*)(ws + WS_VDT);
    vt_scatter(C, z, LD0, Z0_DIL + 1536, 12, 0, 4, 1, vdT);
    vt_scatter(C, z, LD0, Z0_DIL + 1536, 12, 4, 4, 4, vdT);
    vt_scatter(C, z, LD0, Z0_DIL + 1536, 12, 8, 4, 16, vdT);
    norm_heads_inplace(C, z, LD0, Z0_DIL + 768, 12, a.in(19));
}

DI const LAS float* load_t5_lds(const Ctx& C, const KA& a, int col0, int ncols) {
    __syncthreads();
    LAS float* t = (LAS float*)(C.lds + 4096); const float* src = (const float*)(a.ws + WS_T5) + col0 * TABW;
    const int n4 = ncols * TABW / 4;
    for (int i0 = C.tid; i0 < n4; i0 += 2048) {
        f32x4 v[4];
#pragma unroll
        for (int u = 0; u < 4; ++u) { const int i = i0 + 512 * u; v[u] = (i < n4) ? *(const f32x4*)(src + 4 * (size_t)i) : (f32x4){0.f, 0.f, 0.f, 0.f}; }
#pragma unroll
        for (int u = 0; u < 4; ++u) { const int i = i0 + 512 * u; if (i < n4) *(LAS f32x4*)(t + 4 * i) = v[u]; }
    }
    __syncthreads();
    return t + T5RB;
}
template <int DK, bool BIAS, bool SEL, int DSC = 1>
DI void attn_tiles_lds(f32x16& o0, f32x16& o1, float& m, float& l, const bf16x8 (&qf)[DK / 16], const char* kg, size_t kstride, const char* vg, size_t vstride,
                       int kt_lo, int kt_hi, int tq, int tq_min, int tq_max, int W, const LAS float* tab, unsigned selw, int blk_lo, int blk_hi,
                       LAS unsigned char* lds, int tile_off, int tid_in, int n, int h) {
    int tid = tid_in; asm volatile("" : "+v"(tid));
    constexpr int PK = DK * 2 + 16, PV = 136, KB = 64 * PK, BUF = KB + 64 * PV, PPR = DK / 8, NKP = 64 * PPR, NP = NKP + 512, NR = (NP + 511) / 512;
    LAS unsigned char* tbuf = lds + tile_off;
    constexpr bool PF2 = (DK == 64);
    u32x4 r[NR], r2[PF2 ? NR : 1];
#define ATL_GLOAD(kt) do { _Pragma("unroll") for (int rr = 0; rr < NR; ++rr) { const int p = tid + 512 * rr; \
        if ((512 * (rr + 1) <= NKP) || ((512 * rr < NKP) && p < NKP)) r[rr] = *(const u32x4*)(kg + (size_t)(64 * (kt) + p / PPR) * kstride + (p % PPR) * 16); \
        else if ((512 * (rr + 1) <= NP) || p < NP) r[rr] = *(const u32x4*)(vg + (size_t)((p - NKP) >> 3) * vstride + (size_t)(64 * (kt)) * 2 + ((p - NKP) & 7) * 16); } } while (0)
#define ATL_LSTORE(buf) do { LAS unsigned char* bb_ = tbuf + (buf) * BUF; _Pragma("unroll") for (int rr = 0; rr < NR; ++rr) { const int p = tid + 512 * rr; \
        if ((512 * (rr + 1) <= NKP) || ((512 * rr < NKP) && p < NKP)) *(LAS u32x4*)(bb_ + (p / PPR) * PK + (p % PPR) * 16) = r[rr]; \
        else if ((512 * (rr + 1) <= NP) || p < NP) { LAS unsigned char* d_ = bb_ + KB + ((p - NKP) >> 3) * PV + ((p - NKP) & 7) * 16; *(LAS u32x2*)d_ = (u32x2){r[rr].x, r[rr].y}; *(LAS u32x2*)(d_ + 8) = (u32x2){r[rr].z, r[rr].w}; } } } while (0)
    __syncthreads();
    ATL_GLOAD(blk_lo); ATL_LSTORE(blk_lo & 1);
    if (PF2 && blk_lo < blk_hi) ATL_GLOAD(blk_lo + 1);
#pragma unroll 1
    for (int kt = blk_lo; kt <= blk_hi; ++kt) {
        __syncthreads();
        if (!PF2) { if (kt < blk_hi) ATL_GLOAD(kt + 1); }
        else if (kt + 2 <= blk_hi) { _Pragma("unroll") for (int rr = 0; rr < NR; ++rr) { const int p = tid + 512 * rr;
            if ((512 * (rr + 1) <= NKP) || ((512 * rr < NKP) && p < NKP)) r2[rr] = *(const u32x4*)(kg + (size_t)(64 * (kt + 2) + p / PPR) * kstride + (p % PPR) * 16);
            else if ((512 * (rr + 1) <= NP) || p < NP) r2[rr] = *(const u32x4*)(vg + (size_t)((p - NKP) >> 3) * vstride + (size_t)(64 * (kt + 2)) * 2 + ((p - NKP) & 7) * 16); } }
        bool work = (kt >= kt_lo && kt <= kt_hi);
        bool selok = true;
        if (SEL) { selok = ((selw >> kt) & 1u) != 0u; if (__builtin_amdgcn_ballot_w64(selok) == 0ull) work = false; }
        if (work) {
            const LAS unsigned char* bb = tbuf + (kt & 1) * BUF;
            const int k0 = 64 * kt;
            const int dbase = tq - k0 - 4 * h;
            const LAS float* tb = tab - dbase * DSC;
            f32x16 s0, s1;
            if (BIAS) {
#pragma unroll
                for (int i = 0; i < 16; ++i) { const int c = (i & 3) + 8 * (i >> 2); s0[i] = tb[c * DSC]; s1[i] = tb[(c + 32) * DSC]; }
            } else {
#pragma unroll
                for (int i = 0; i < 16; ++i) { s0[i] = 0.f; s1[i] = 0.f; }
            }
#pragma unroll
            for (int ks = 0; ks < DK / 16; ++ks) { const bf16x8 ka = *(const LAS bf16x8*)(bb + n * PK + (16 * ks + 8 * h) * 2), kb2 = *(const LAS bf16x8*)(bb + (32 + n) * PK + (16 * ks + 8 * h) * 2);
                s0 = MFMA32(ka, qf[ks], s0); s1 = MFMA32(kb2, qf[ks], s1); }
            const bool interior = (tq_min >= k0 + 63) && (tq_max - k0 < W) && (!SEL || __builtin_amdgcn_ballot_w64(!selok) == 0ull);
            if (!interior) {
#pragma unroll
                for (int i = 0; i < 16; ++i) { const int c = (i & 3) + 8 * (i >> 2);
                    s0[i] = ((unsigned)(dbase - c) < (unsigned)W && selok) ? s0[i] : -INFINITY;
                    s1[i] = ((unsigned)(dbase - c - 32) < (unsigned)W && selok) ? s1[i] : -INFINITY; }
            }
            float mxa = max3f(s0[0], s1[0], s0[1]), mxb = max3f(s1[1], s0[2], s1[2]);
#pragma unroll
            for (int i = 3; i < 15; i += 2) { mxa = max3f(mxa, s0[i], s1[i]); mxb = max3f(mxb, s0[i + 1], s1[i + 1]); }
            float mx = max3f(mxa, mxb, max2f(s0[15], s1[15]));
            mx = max2f(mx, __shfl_xor(mx, 32));
            if (__builtin_amdgcn_ballot_w64(mx - m > 8.0f) != 0ull) {
                const float mn = fmaxf(m, mx), mu_ = (mn == -INFINITY) ? 0.f : mn;
                const float alpha = fexp2(m - mu_); m = mn; l *= alpha;
#pragma unroll
                for (int i = 0; i < 16; ++i) { o0[i] *= alpha; o1[i] *= alpha; }
            }
            const float mu = (m == -INFINITY) ? 0.f : m;
            float rs = 0.f;
#pragma unroll
            for (int i = 0; i < 16; i += 2) {
                f32x2_t a2 = {s0[i], s0[i + 1]}, b2 = {s1[i], s1[i + 1]}; const f32x2_t nm = {-mu, -mu};
                a2 = a2 + nm; b2 = b2 + nm;
                s0[i] = fexp2(a2.x); s0[i + 1] = fexp2(a2.y); s1[i] = fexp2(b2.x); s1[i + 1] = fexp2(b2.y);
                rs += (s0[i] + s0[i + 1]) + (s1[i] + s1[i + 1]); }
            l += rs;
            bf16x8 pb[4];
            { u32x4 p; p.x = cvtpk(s0[0], s0[1]); p.y = cvtpk(s0[2], s0[3]); p.z = cvtpk(s0[4], s0[5]); p.w = cvtpk(s0[6], s0[7]); pb[0] = __builtin_bit_cast(bf16x8, p);
              p.x = cvtpk(s0[8], s0[9]); p.y = cvtpk(s0[10], s0[11]); p.z = cvtpk(s0[12], s0[13]); p.w = cvtpk(s0[14], s0[15]); pb[1] = __builtin_bit_cast(bf16x8, p);
              p.x = cvtpk(s1[0], s1[1]); p.y = cvtpk(s1[2], s1[3]); p.z = cvtpk(s1[4], s1[5]); p.w = cvtpk(s1[6], s1[7]); pb[2] = __builtin_bit_cast(bf16x8, p);
              p.x = cvtpk(s1[8], s1[9]); p.y = cvtpk(s1[10], s1[11]); p.z = cvtpk(s1[12], s1[13]); p.w = cvtpk(s1[14], s1[15]); pb[3] = __builtin_bit_cast(bf16x8, p); }
            const LAS unsigned char* vb = bb + KB + n * PV + 8 * h;
#pragma unroll
            for (int sx = 0; sx < 4; ++sx) {
                const s16x4 a0 = *(const LAS s16x4*)(vb + 32 * sx), a1 = *(const LAS s16x4*)(vb + 32 * sx + 16);
                const s16x4 b0 = *(const LAS s16x4*)(vb + 32 * PV + 32 * sx), b1 = *(const LAS s16x4*)(vb + 32 * PV + 32 * sx + 16);
                o0 = MFMA32(__builtin_shufflevector(a0, a1, 0, 1, 2, 3, 4, 5, 6, 7), pb[sx], o0);
                o1 = MFMA32(__builtin_shufflevector(b0, b1, 0, 1, 2, 3, 4, 5, 6, 7), pb[sx], o1);
            }
        }
        if (kt < blk_hi) ATL_LSTORE((kt + 1) & 1);
        if (PF2) {
#pragma unroll
            for (int rr = 0; rr < NR; ++rr) r[rr] = r2[rr];
        }
    }
#undef ATL_GLOAD
#undef ATL_LSTORE
}

DI void phase_att0(const Ctx& C, const KA& a) {
    unsigned char* ws = a.ws; const int n = C.n, h = C.h;
    bf16_t* z = (bf16_t*)(ws + WS_H);
    for (int prep_ = 0; prep_ < ((PROBE_SUB == 1) ? 2 : 1); ++prep_) {
        const bf16_t* qm = (const bf16_t*)(ws + WS_QM); const bf16_t* km = (const bf16_t*)(ws + WS_KM); const bf16_t* vmT = (const bf16_t*)(ws + WS_VMT);
        for (int it = 0;; ++it) {
            const int ge = deal(it, (int)blockIdx.x, C.G, 1024); if (ge < 0) { if ((long)it * C.G >= 1024) break; else continue; }
            const int qg = ge >> 7, bh = ge & 127, b = bh >> 3, head = bh & 7, qt = 8 * qg + C.wave;
            const int t = 32 * qt + n;
            bf16x8 qf[6];
            const bf16_t* qr = qm + ((size_t)bh * SEQ + t) * 96 + 8 * h;
#pragma unroll
            for (int ks = 0; ks < 6; ++ks) qf[ks] = *(const bf16x8*)(qr + 16 * ks);
            f32x16 o0, o1; zero16(o0); zero16(o1); float m = -INFINITY, l = 0.f;
            attn_tiles_lds<96, false, false>(o0, o1, m, l, qf, (const char*)(km + (size_t)bh * SEQ * 96), 192, (const char*)(vmT + (size_t)bh * 64 * SEQ), (size_t)SEQ * 2,
                                             0, qt >> 1, t, 32 * qt, 32 * qt + 31, 1 << 30, (const LAS float*)C.lds, 0u, 0, 4 * qg + 3, C.lds, 4096, C.tid, n, h);
            l += __shfl_xor(l, 32);
            store_o64(z + (size_t)(b * SEQ + t) * LD0 + Z0_MIX + head * 64, o0, o1, 1.0f / l, h);
        }
    }
    for (int prep_ = 0; prep_ < ((PROBE_SUB == 2) ? 2 : 1); ++prep_) {
        const LAS float* t5 = load_t5_lds(C, a, 0, 12);
        const bf16_t* vdT = (const bf16_t*)(ws + WS_VDT); bf16_t* og = (bf16_t*)(a.outb + OUT_OG); float* lse = (float*)(a.outb + OUT_LSE);
        const float* qg = a.in(18);
        for (int unit = (int)blockIdx.x; unit < 2048; unit += C.G) {
            int g, rem; if (unit < 512) { g = 0; rem = unit; } else if (unit < 1024) { g = 1; rem = unit - 512; } else { g = 2; rem = unit - 1024; }
            const int d = (g == 0) ? 1 : (g == 1 ? 4 : 16), Sd = SEQ / d;
            const int upbh = (g == 2) ? 16 : 8;
            const int bhh = rem / upbh, sub = rem % upbh, b = bhh >> 2, hgi = bhh & 3;
            const int spr = (g == 0) ? 8 : (g == 1 ? 2 : 1);
            const int r = sub / spr, pg = sub % spr;
            const int head12 = g * 4 + hgi, pt = 8 * pg + C.wave;
            const bool active = (32 * pt) < Sd;
            const int tp = active ? 32 * pt + n : n, tok = b * SEQ + tp * d + r;
            bf16x8 qf[4];
            load_q64(qf, z + (size_t)tok * LD0 + Z0_DIL + head12 * 64, qg, 0.125f * LOG2E, h);
            f32x16 o0, o1; zero16(o0); zero16(o1); float m = -INFINITY, l = 0.f;
            const int blo64 = (256 * pg - 128) > 0 ? ((256 * pg - 128) >> 6) : 0; const int bhi_ = 4 * pg + 3, bmax = Sd / 64 - 1; const int bhi64 = bhi_ < bmax ? bhi_ : bmax;
            int klo = (32 * pt - 128) > 0 ? ((32 * pt - 128) >> 6) : 0, khi = (32 * pt + 31) >> 6; if (!active) { klo = 1; khi = 0; }
            const char* kg = (const char*)(z + (size_t)(b * SEQ + r) * LD0 + Z0_DIL + 768 + head12 * 64);
            const char* vg = (const char*)(vdT + ((size_t)(b * 12 + head12) * 64) * SEQ + r * Sd);
            const LAS float* tab = t5 + head12 * TABW;
            if (g == 0) attn_tiles_lds<64, true, false, 1>(o0, o1, m, l, qf, kg, (size_t)LD0 * 2, vg, (size_t)SEQ * 2, klo, khi, tp, 32 * pt, 32 * pt + 31, 129, tab, 0u, blo64, bhi64, C.lds, 106496, C.tid, n, h);
            else if (g == 1) attn_tiles_lds<64, true, false, 4>(o0, o1, m, l, qf, kg, (size_t)LD0 * 8, vg, (size_t)SEQ * 2, klo, khi, tp, 32 * pt, 32 * pt + 31, 129, tab, 0u, blo64, bhi64, C.lds, 106496, C.tid, n, h);
            else attn_tiles_lds<64, true, false, 16>(o0, o1, m, l, qf, kg, (size_t)LD0 * 32, vg, (size_t)SEQ * 2, klo, khi, tp, 32 * pt, 32 * pt + 31, 129, tab, 0u, blo64, bhi64, C.lds, 106496, C.tid, n, h);
            if (active) {
                l += __shfl_xor(l, 32);
                store_o64(og + (((size_t)g * TOK + tok) * 4 + hgi) * 64, o0, o1, 1.0f / l, h);
                if (h == 0) lse[((size_t)g * TOK + tok) * 4 + hgi] = m + log2f(l);
            }
        }
    }
}

DI void phase_comb0(const Ctx& C, const KA& a) {
    unsigned char* ws = a.ws; bf16_t* z = (bf16_t*)(ws + WS_H);
    const bf16_t* og = (const bf16_t*)(a.outb + OUT_OG); const float* lse = (const float*)(a.outb + OUT_LSE);
    const long total = (long)TOK * 4 * 8;
    for (long i = (long)C.gw * 64 + C.lane; i < total; i += (long)C.NGW * 64) {
        const int c8 = (int)(i & 7); const long th = i >> 3; const int hg = (int)(th & 3); const int tok = (int)(th >> 2);
        const float l0 = lse[(size_t)tok * 4 + hg], l1 = lse[((size_t)TOK + tok) * 4 + hg], l2 = lse[((size_t)2 * TOK + tok) * 4 + hg];
        const float mx = fmaxf(l0, fmaxf(l1, l2));
        float w0 = fexp2(l0 - mx), w1 = fexp2(l1 - mx), w2 = fexp2(l2 - mx); const float inv = 1.0f / (w0 + w1 + w2); w0 *= inv; w1 *= inv; w2 *= inv;
        const u32x4 a0 = *(const u32x4*)(og + ((size_t)tok * 4 + hg) * 64 + 8 * c8), a1 = *(const u32x4*)(og + (((size_t)TOK + tok) * 4 + hg) * 64 + 8 * c8), a2 = *(const u32x4*)(og + (((size_t)2 * TOK + tok) * 4 + hg) * 64 + 8 * c8);
        u32x4 w;
#pragma unroll
        for (int j = 0; j < 4; ++j) w[j] = cvtpk(w0 * bflo(a0[j]) + w1 * bflo(a1[j]) + w2 * bflo(a2[j]), w0 * bfhi(a0[j]) + w1 * bfhi(a1[j]) + w2 * bfhi(a2[j]));
        *(u32x4*)(z + (size_t)tok * LD0 + Z0_MIX + 512 + hg * 64 + 8 * c8) = w;
    }
}

constexpr int Z1_SQ = 0, Z1_SK = 512, Z1_SV = 640, Z1_NQ = 768, Z1_KC = 1280, Z1_VC = 1408, Z1_KS = 1536, Z1_VS = 1664, Z1_KW = 1792, Z1_VW = 1920, Z1_G = 2048;

DI float gelu_tanh(float x) {
    const float u = 0.7978845608028654f * (x + 0.044715f * x * x * x);
    const float e = fexp2(-2.0f * LOG2E * fabsf(u)); const float th = (1.0f - e) * frcp(1.0f + e);
    return 0.5f * x * (1.0f + (u < 0.f ? -th : th));
}
DI void cmp_item(const Ctx& C, const KA& a, int item) {
    unsigned char* ws = a.ws; const int n = C.n, h = C.h;
    const int ct = item & 3, which = (item >> 2) & 1, g = (item >> 3) & 1, b = item >> 4;
    const bf16_t* z = (const bf16_t*)(ws + WS_H);
    int c = 32 * ct + n; const int cl = c < 127 ? c : 126;
    const bf16_t* zr = z + (size_t)(b * SEQ + 16 * cl) * LD1 + (which ? Z1_VC : Z1_KC) + g * 64 + 8 * h;
    const bf16_t* W1 = (const bf16_t*)(ws + WS_WC1) + (size_t)which * 128 * 2048; const bf16_t* W2 = (const bf16_t*)(ws + WS_WC2) + (size_t)which * 64 * 128;
    f32x16 hid[4];
#pragma unroll
    for (int ft = 0; ft < 4; ++ft) zero16(hid[ft]);
#pragma unroll 1
    for (int lq = 0; lq < 4; ++lq) {
        const int lt = 4 * C.wave + lq;
#pragma unroll
        for (int ks = 0; ks < 4; ++ks) {
            const bf16x8 bq = *(const bf16x8*)(zr + (size_t)lt * LD1 + 16 * ks);
#pragma unroll
            for (int ft = 0; ft < 4; ++ft) { const bf16x8 wa = *(const bf16x8*)(W1 + (size_t)(32 * ft + n) * 2048 + lt * 64 + 16 * ks + 8 * h); hid[ft] = MFMA32(wa, bq, hid[ft]); }
        }
    }
    LAS float* part = (LAS float*)C.lds;
    __syncthreads();
#pragma unroll
    for (int ft = 0; ft < 4; ++ft)
#pragma unroll
        for (int i = 0; i < 16; ++i) part[((C.wave * 4 + ft) * 16 + i) * 64 + C.lane] = hid[ft][i];
    __syncthreads();
    if (C.wave != 0) return;
#pragma unroll
    for (int ft = 0; ft < 4; ++ft)
#pragma unroll
        for (int i = 0; i < 16; ++i) { float t = 0.f;
#pragma unroll
            for (int w = 0; w < 8; ++w) t += part[((w * 4 + ft) * 16 + i) * 64 + C.lane];
            hid[ft][i] = t; }
    const float* cb = (const float*)(ws + WS_CB) + which * 128;
    f32x16 o0, o1; zero16(o0); zero16(o1);
#pragma unroll
    for (int ft = 0; ft < 4; ++ft) {
        float gv[16];
#pragma unroll
        for (int i = 0; i < 16; ++i) gv[i] = gelu_tanh(hid[ft][i] + cb[32 * ft + crow(i, h)]);
#pragma unroll
        for (int s = 0; s < 2; ++s) {
            u32x4 p; p.x = cvtpk(gv[8 * s], gv[8 * s + 1]); p.y = cvtpk(gv[8 * s + 2], gv[8 * s + 3]); p.z = cvtpk(gv[8 * s + 4], gv[8 * s + 5]); p.w = cvtpk(gv[8 * s + 6], gv[8 * s + 7]);
            const bf16x8 pb = __builtin_bit_cast(bf16x8, p);
            const bf16_t* w2 = W2 + (size_t)n * 128 + 32 * ft + 16 * s + 4 * h;
            const s16x4 a0 = *(const s16x4*)(w2), a1 = *(const s16x4*)(w2 + 8);
            const s16x4 b0 = *(const s16x4*)(w2 + 32 * 128), b1 = *(const s16x4*)(w2 + 32 * 128 + 8);
            o0 = MFMA32(__builtin_shufflevector(a0, a1, 0, 1, 2, 3, 4, 5, 6, 7), pb, o0);
            o1 = MFMA32(__builtin_shufflevector(b0, b1, 0, 1, 2, 3, 4, 5, 6, 7), pb, o1);
        }
    }
    if (which == 0) {
        float ss = 0.f;
#pragma unroll
        for (int i = 0; i < 16; ++i) ss += o0[i] * o0[i] + o1[i] * o1[i];
        ss += __shfl_xor(ss, 32);
        const float r = 1.0f / sqrtf(ss * (1.0f / 64.0f) + EPS);
        const float* kg = a.in(26);
        bf16_t* dst = (bf16_t*)(ws + WS_KC) + ((size_t)(b * 2 + g) * 128 + c) * 64;
#pragma unroll
        for (int q = 0; q < 4; ++q) { const int f = 8 * q + 4 * h; const f32x4 g0 = *(const f32x4*)(kg + f), g1 = *(const f32x4*)(kg + 32 + f);
            u32x2 w; w.x = cvtpk(o0[4 * q] * r * g0.x, o0[4 * q + 1] * r * g0.y); w.y = cvtpk(o0[4 * q + 2] * r * g0.z, o0[4 * q + 3] * r * g0.w); *(u32x2*)(dst + f) = w;
            u32x2 w2; w2.x = cvtpk(o1[4 * q] * r * g1.x, o1[4 * q + 1] * r * g1.y); w2.y = cvtpk(o1[4 * q + 2] * r * g1.z, o1[4 * q + 3] * r * g1.w); *(u32x2*)(dst + 32 + f) = w2; }
    } else {
        bf16_t* dst_ = (bf16_t*)(ws + WS_VCT) + ((size_t)(b * 2 + g) * 64 + 4 * h) * 128 + c; asm volatile("" : "+v"(dst_)); gbf16_t* dst = (gbf16_t*)dst_;
#pragma unroll
        for (int i = 0; i < 16; ++i) { dst[(size_t)crow(i, 0) * 128] = (bf16_t)(cvtpk(o0[i], 0.f) & 0xffffu); dst[(size_t)(32 + crow(i, 0)) * 128] = (bf16_t)(cvtpk(o1[i], 0.f) & 0xffffu); }
    }
}

DI void phase_prep1(const Ctx& C, const KA& a) {
    unsigned char* ws = a.ws; bf16_t* z = (bf16_t*)(ws + WS_H);
    for (int it = (int)blockIdx.x; it < 256; it += C.G) cmp_item(C, a, it);
    bf16_t* vt = (bf16_t*)(ws + WS_VT1); const size_t VTS = (size_t)BATCH * 2 * 64 * SEQ;
    vt_scatter(C, z, LD1, Z1_SV, 2, 0, 2, 1, vt);
    vt_scatter(C, z, LD1, Z1_VS, 2, 0, 2, 1, vt + VTS);
    vt_scatter(C, z, LD1, Z1_VW, 2, 0, 2, 1, vt + 2 * VTS);
    norm_heads_inplace(C, z, LD1, Z1_SK, 2, a.in(23));
    norm_heads_inplace(C, z, LD1, Z1_KS, 2, a.in(26) + 64);
    norm_heads_inplace(C, z, LD1, Z1_KW, 2, a.in(26) + 128);
}

DI float quad_sum(float v) {
    v += __builtin_bit_cast(float, __builtin_amdgcn_update_dpp(0, __builtin_bit_cast(int, v), 0xB1, 0xf, 0xf, true));
    v += __builtin_bit_cast(float, __builtin_amdgcn_update_dpp(0, __builtin_bit_cast(int, v), 0x4E, 0xf, 0xf, true));
    return v; }

DI void phase_att1(const Ctx& C, const KA& a) {
    unsigned char* ws = a.ws; const int n = C.n, h = C.h, r = n & 3, tl = n >> 2;
    const LAS float* t5 = load_t5_lds(C, a, 8, 8);
    const bf16_t* z = (const bf16_t*)(ws + WS_H); bf16_t* mixed = (bf16_t*)(ws + WS_MIX1);
    const bf16_t* vt = (const bf16_t*)(ws + WS_VT1); const size_t VTS = (size_t)BATCH * 2 * 64 * SEQ;
    const float qsc = 0.125f * LOG2E;
    for (int prep_ = 0; prep_ < ((PROBE_SUB == 3) ? 2 : 1); ++prep_)
    for (int it = 0;; ++it) {
        const int ge = deal(it, (int)blockIdx.x, C.G, 1024); if (ge < 0) { if ((long)it * C.G >= 1024) break; else continue; }
        const int tg = ge >> 5, bg = ge & 31, b = bg >> 1, g = bg & 1, head = g * 4 + r, tt = 8 * tg + C.wave;
        const int t = 8 * tt + tl, tok = b * SEQ + t;
        bf16x8 qf[4];
        load_q64(qf, z + (size_t)tok * LD1 + Z1_NQ + head * 64, a.in(25), qsc, h);
        const bf16_t* gz = z + (size_t)tok * LD1 + Z1_G + head * 3;
        const float g_cmp = frcp(1.0f + fexp2(-LOG2E * bf2f(gz[0]))), g_slc = frcp(1.0f + fexp2(-LOG2E * bf2f(gz[1]))), g_win = frcp(1.0f + fexp2(-LOG2E * bf2f(gz[2])));
        f32x16 r0, r1;
        unsigned selw;
        {
            constexpr int CKP = 144, CVP = 264, CVOFF = 128 * CKP;
            LAS unsigned char* cbuf = C.lds + 73728;
            __syncthreads();
            {
                const unsigned char* kcg = (const unsigned char*)((const bf16_t*)(ws + WS_KC) + (size_t)bg * 128 * 64);
                const unsigned char* vcg = (const unsigned char*)((const bf16_t*)(ws + WS_VCT) + (size_t)bg * 64 * 128);
#pragma unroll
                for (int rr = 0; rr < 2; ++rr) { const int p = C.tid + 512 * rr;
                    const u32x4 kv = *(const u32x4*)(kcg + (size_t)p * 16); *(LAS u32x4*)(cbuf + (p >> 3) * CKP + (p & 7) * 16) = kv;
                    const u32x4 vv = *(const u32x4*)(vcg + (size_t)p * 16); LAS unsigned char* dv = cbuf + CVOFF + (p >> 4) * CVP + (p & 15) * 16;
                    *(LAS u32x2*)dv = (u32x2){vv.x, vv.y}; *(LAS u32x2*)(dv + 8) = (u32x2){vv.z, vv.w}; }
            }
            __syncthreads();
            const LAS unsigned char* kc = cbuf + n * CKP + 16 * h;
            const LAS unsigned char* vc = cbuf + CVOFF + n * CVP + 8 * h;
            const int cmax = (t >= 31) ? ((t - 31) >> 4) : -1;
            float mx = -INFINITY;
#pragma unroll
            for (int kt = 0; kt < 4; ++kt) { f32x16 s; zero16(s); int lim = cmax - 4 * h; asm volatile("" : "+v"(lim));
#pragma unroll
                for (int ks = 0; ks < 4; ++ks) { const bf16x8 ka = *(const LAS bf16x8*)(kc + kt * 32 * CKP + 32 * ks); s = MFMA32(ka, qf[ks], s); }
#pragma unroll
                for (int i = 0; i < 16; ++i) { const int c = 32 * kt + crow(i, 0); mx = fmaxf(mx, (c <= lim) ? s[i] : -INFINITY); }
                asm volatile("" ::: "memory"); }
            mx = fmaxf(mx, __shfl_xor(mx, 32));
            const float mu = (mx == -INFINITY) ? 0.f : mx; float sum = 0.f;
#pragma unroll
            for (int kt = 0; kt < 4; ++kt) { f32x16 s; zero16(s); int lim = cmax - 4 * h; asm volatile("" : "+v"(lim));
#pragma unroll
                for (int ks = 0; ks < 4; ++ks) { const bf16x8 ka = *(const LAS bf16x8*)(kc + kt * 32 * CKP + 32 * ks); s = MFMA32(ka, qf[ks], s); }
#pragma unroll
                for (int i = 0; i < 16; ++i) { const int c = 32 * kt + crow(i, 0); sum += (c <= lim) ? fexp2(s[i] - mu) : 0.f; }
                asm volatile("" ::: "memory"); }
            sum += __shfl_xor(sum, 32);
            const float inv = 1.0f / fmaxf(sum, 1e-30f);
            float own[16], lastv[16];
            f32x16 o0, o1; zero16(o0); zero16(o1);
#pragma unroll
            for (int kt = 0; kt < 4; ++kt) { f32x16 s; zero16(s); int lim = cmax - 4 * h; asm volatile("" : "+v"(lim));
#pragma unroll
                for (int ks = 0; ks < 4; ++ks) { const bf16x8 ka = *(const LAS bf16x8*)(kc + kt * 32 * CKP + 32 * ks); s = MFMA32(ka, qf[ks], s); }
#pragma unroll
                for (int i = 0; i < 16; ++i) { const int c = 32 * kt + crow(i, 0); s[i] = (c <= lim) ? fexp2(s[i] - mu) * inv : 0.f; }
#pragma unroll
                for (int q = 0; q < 4; ++q) { const float p3 = quad_sum(s[4 * q + 3]); const float p012 = quad_sum(s[4 * q] + s[4 * q + 1] + s[4 * q + 2]); own[4 * kt + q] = p012 + p3; lastv[4 * kt + q] = p3; }
#pragma unroll
                for (int sx = 0; sx < 2; ++sx) {
                    u32x4 p; p.x = cvtpk(s[8 * sx], s[8 * sx + 1]); p.y = cvtpk(s[8 * sx + 2], s[8 * sx + 3]); p.z = cvtpk(s[8 * sx + 4], s[8 * sx + 5]); p.w = cvtpk(s[8 * sx + 6], s[8 * sx + 7]);
                    const bf16x8 pb = __builtin_bit_cast(bf16x8, p);
                    const LAS unsigned char* vp = vc + 64 * kt + 32 * sx;
                    const s16x4 a0 = *(const LAS s16x4*)(vp), a1 = *(const LAS s16x4*)(vp + 16), b0 = *(const LAS s16x4*)(vp + 32 * CVP), b1 = *(const LAS s16x4*)(vp + 32 * CVP + 16);
                    o0 = MFMA32(__builtin_shufflevector(a0, a1, 0, 1, 2, 3, 4, 5, 6, 7), pb, o0);
                    o1 = MFMA32(__builtin_shufflevector(b0, b1, 0, 1, 2, 3, 4, 5, 6, 7), pb, o1);
                }
                asm volatile("" ::: "memory"); }
#pragma unroll
            for (int i = 0; i < 16; ++i) { r0[i] = g_cmp * o0[i]; r1[i] = g_cmp * o1[i]; }
            float imp[32];
#pragma unroll
            for (int idx = 0; idx < 16; ++idx) {
                const float rl = __shfl_xor(lastv[idx], 32);
                const float rlm = (idx > 0) ? __shfl_xor(lastv[idx > 0 ? idx - 1 : 0], 32) : 0.f;
                const float mine = own[idx] + (h ? rl : rlm);
                const float theirs = __shfl_xor(mine, 32);
                imp[2 * idx] = h ? theirs : mine; imp[2 * idx + 1] = h ? mine : theirs;
            }
            const int tb = tt >> 3;
            if (tb <= 15) selw = (2u << tb) - 1u;
            else {
                unsigned sel = 0u;
#pragma unroll
                for (int j2 = 0; j2 < 32; ++j2) imp[j2] = (j2 >= 1 && j2 <= tb - 2) ? imp[j2] : -1.0f;
                const int sub8 = (n & 3) + 4 * h;
#pragma unroll 1
                for (int j = 1 + sub8; j <= tb - 2; j += 8) {
                    float ij = 0.f;
#pragma unroll
                    for (int j2 = 1; j2 < 30; ++j2) ij = (j2 == j) ? imp[j2] : ij;
                    int rank = 0;
#pragma unroll
                    for (int j2 = 1; j2 < 30; ++j2) rank += ((j2 < j) ? (imp[j2] >= ij) : (imp[j2] > ij)) ? 1 : 0;
                    if (rank < 13) sel |= (1u << j);
                }
                sel |= (unsigned)__shfl_xor((int)sel, 1); sel |= (unsigned)__shfl_xor((int)sel, 2); sel |= (unsigned)__shfl_xor((int)sel, 32);
                sel |= 1u | (1u << tb) | (1u << (tb - 1));
                selw = sel;
            }
        }
        {
            f32x16 o0, o1; zero16(o0); zero16(o1); float m = -INFINITY, l = 0.f;
            attn_tiles_lds<64, true, true>(o0, o1, m, l, qf, (const char*)(z + (size_t)(b * SEQ) * LD1 + Z1_KS + g * 64), (size_t)LD1 * 2, (const char*)(vt + VTS + (size_t)bg * 64 * SEQ), (size_t)SEQ * 2,
                                           0, tg, t, 8 * tt, 8 * tt + 7, 1 << 30, t5 + head * TABW, selw, 0, tg, C.lds, 73728, C.tid, n, h);
            l += __shfl_xor(l, 32); const float sc = g_slc / l;
#pragma unroll
            for (int i = 0; i < 16; ++i) { r0[i] += sc * o0[i]; r1[i] += sc * o1[i]; }
        }
        {
            f32x16 o0, o1; zero16(o0); zero16(o1); float m = -INFINITY, l = 0.f;
            const int wlo = tg > 8 ? tg - 8 : 0;
            attn_tiles_lds<64, true, false>(o0, o1, m, l, qf, (const char*)(z + (size_t)(b * SEQ) * LD1 + Z1_KW + g * 64), (size_t)LD1 * 2, (const char*)(vt + 2 * VTS + (size_t)bg * 64 * SEQ), (size_t)SEQ * 2,
                                            wlo, tg, t, 8 * tt, 8 * tt + 7, 512, t5 + head * TABW, 0u, wlo, tg, C.lds, 73728, C.tid, n, h);
            l += __shfl_xor(l, 32); const float sc = g_win / l;
#pragma unroll
            for (int i = 0; i < 16; ++i) { r0[i] += sc * o0[i]; r1[i] += sc * o1[i]; }
        }
        { int tok2 = b * SEQ + t; asm volatile("" : "+v"(tok2));
          store_o64(mixed + (size_t)tok2 * DM + 512 + head * 64, r0, r1, 1.0f, h); }
    }
    for (int prep_ = 0; prep_ < ((PROBE_SUB == 4) ? 2 : 1); ++prep_) {
        t5 = load_t5_lds(C, a, 0, 8);
        const float* sinks = a.in(24);
        for (int gi = (int)blockIdx.x; gi < 1024; gi += C.G) {
            const int tg = gi >> 5, bg = gi & 31, b = bg >> 1, g = bg & 1, head = g * 4 + r, tt = 8 * tg + C.wave;
            const int t = 8 * tt + tl, tok = b * SEQ + t;
            bf16x8 qf[4];
            load_q64(qf, z + (size_t)tok * LD1 + Z1_SQ + head * 64, a.in(22), qsc, h);
            f32x16 o0, o1; zero16(o0); zero16(o1); float m = -INFINITY, l = 0.f;
            const int wlo = tg > 2 ? tg - 2 : 0;
            attn_tiles_lds<64, true, false>(o0, o1, m, l, qf, (const char*)(z + (size_t)(b * SEQ) * LD1 + Z1_SK + g * 64), (size_t)LD1 * 2, (const char*)(vt + (size_t)bg * 64 * SEQ), (size_t)SEQ * 2,
                                            wlo, tg, t, 8 * tt, 8 * tt + 7, 128, t5 + head * TABW, 0u, wlo, tg, C.lds, 73728, C.tid, n, h);
            l += __shfl_xor(l, 32);
            const float sk = sinks[head] * LOG2E; const float mf = fmaxf(m, sk);
            const float den = l * fexp2(m - mf) + fexp2(sk - mf);
            store_o64(mixed + (size_t)tok * DM + head * 64, o0, o1, fexp2(m - mf) / den, h);
        }
    }
}


constexpr size_t WS_CTL = WS_SMALL + 6 * MiB;
constexpr int LDS_BAR_OFF = 147456 - 64;
#define XB_TMO      128
#define XB_XCNT(j)  (256  + 64 * (j))
#define XB_XSUB(j)  (1280 + 64 * (j))
#define XB_XGEN(j)  (2304 + 64 * (j))
#define XB_TOP      3328
#define XB_TOPGEN   3392
#define XCD_BAR_WORDS 3456
#define XB_SPIN_CAP (1u << 26)
DI unsigned xb_ld(unsigned* p)              { return __hip_atomic_load(p, __ATOMIC_RELAXED, __HIP_MEMORY_SCOPE_AGENT); }
DI unsigned xb_add(unsigned* p, unsigned v) { return __hip_atomic_fetch_add(p, v, __ATOMIC_RELAXED, __HIP_MEMORY_SCOPE_AGENT); }
DI unsigned xb_xcc_id() { return (unsigned)__builtin_amdgcn_s_getreg((3 << 11) | 20) & 0xFu; }
#define XB_SPIN(cond, bar) do { unsigned _sp = 0; while (cond) { __builtin_amdgcn_s_sleep(1); \
    if ((++_sp & 255u) == 0u) { if (xb_ld(&(bar)[XB_TMO])) break; if (_sp > XB_SPIN_CAP) { atomicAdd(&(bar)[XB_TMO], 1u); break; } } } } while (0)
struct XcdBarrier { unsigned* bar; unsigned x; volatile LAS unsigned* st; };
DI XcdBarrier xcd_barrier_post(unsigned* bar, volatile LAS unsigned* st) {
    XcdBarrier b; b.bar = bar; b.x = xb_xcc_id(); b.st = st;
    if (threadIdx.x == 0) (void)xb_add(&bar[XB_XCNT(b.x)], 1u);
    return b;
}
DI void xcd_barrier_complete(unsigned* bar, unsigned x, unsigned& nloc, unsigned& nx) {
    const unsigned G = gridDim.x * gridDim.y * gridDim.z;
    unsigned sum, cnt, mine, sp = 0u;
    for (;;) {
        sum = 0u; cnt = 0u; mine = 0u;
#pragma unroll
        for (unsigned j = 0; j < 16; ++j) { const unsigned c = xb_ld(&bar[XB_XCNT(j)]); sum += c; cnt += (c > 0u) ? 1u : 0u; mine = (j == x) ? c : mine; }
        if (sum == G) break;
        __builtin_amdgcn_s_sleep(1);
        if ((++sp & 255u) == 0u) { if (xb_ld(&bar[XB_TMO])) break; if (sp > XB_SPIN_CAP) { atomicAdd(&bar[XB_TMO], 1u); break; } }
    }
    nloc = mine > 0u ? mine : 1u; nx = cnt > 0u ? cnt : 1u;
}
DI void xcd_barrier(const XcdBarrier& b) {
    asm volatile("s_waitcnt vmcnt(0)" ::: "memory");
    __syncthreads();
    if (threadIdx.x == 0) {
        unsigned* bar = b.bar;
        __builtin_amdgcn_s_waitcnt(0);
        unsigned nloc = b.st[0], nx = b.st[1];
        if (nloc == 0u) { xcd_barrier_complete(bar, b.x, nloc, nx); b.st[0] = nloc; b.st[1] = nx; }
        const unsigned old = xb_add(&bar[XB_XSUB(b.x)], 1u);
        const unsigned gen = old / nloc;
        if (old + 1u == (gen + 1u) * nloc) {
            __builtin_amdgcn_fence(__ATOMIC_RELEASE, "agent");
            asm volatile("s_waitcnt vmcnt(0)" ::: "memory");
            const unsigned og = xb_add(&bar[XB_TOP], 1u);
            const unsigned tg = og / nx;
            if (og + 1u == (tg + 1u) * nx) xb_add(&bar[XB_TOPGEN], 1u);
            else XB_SPIN(xb_ld(&bar[XB_TOPGEN]) == tg, bar);
            __builtin_amdgcn_fence(__ATOMIC_ACQUIRE, "agent");
            xb_add(&bar[XB_XGEN(b.x)], 1u);
            asm volatile("s_waitcnt vmcnt(0)" ::: "memory");
        } else {
            XB_SPIN(xb_ld(&bar[XB_XGEN(b.x)]) == gen, bar);
            __builtin_amdgcn_fence(__ATOMIC_ACQUIRE, "agent");
            asm volatile("s_waitcnt vmcnt(0)" ::: "memory");
        }
    }
    __syncthreads();
}

constexpr int NPHASE = 18;
#ifndef PROBE_PH
#define PROBE_PH (-1)
#endif
#define PHON(k) (((MASK) >> (k)) & 1)
constexpr int LDS_BYTES = 147456;

template <int MASK> __global__ void __launch_bounds__(512, 2) mega_fwd(Args a) {
    extern __shared__ __attribute__((aligned(16))) unsigned char lds_raw[];
    cg::grid_group grid = cg::this_grid();
    if (a.ph_hi - a.ph_lo > 1) {
        volatile LAS unsigned* st = (volatile LAS unsigned*)((LAS unsigned char*)lds_raw + LDS_BAR_OFF);
        if (threadIdx.x < 2) st[threadIdx.x] = 0u;
        __syncthreads();
        (void)xcd_barrier_post((unsigned*)(a.ws + WS_CTL), st);
        grid.sync();
    }
    for (int ph = a.ph_lo; ph < a.ph_hi; ++ph) {
#define MKCTX() Ctx C; { int tid_ = threadIdx.x; asm volatile("" : "+v"(tid_)); C.lds = (LAS unsigned char*)lds_raw; C.tid = tid_; C.lane = C.tid & 63; C.wave = __builtin_amdgcn_readfirstlane(C.tid >> 6); \
        C.n = C.lane & 31; C.h = C.lane >> 5; { int G_ = gridDim.x; asm volatile("" : "+s"(G_)); C.G = G_; } C.gw = blockIdx.x * 8 + C.wave; C.NGW = C.G * 8; }
        KA ka; ka.k = (kptr_t)__builtin_amdgcn_kernarg_segment_ptr(); asm volatile("" : "+s"(ka.k));
        ka.ws = *(unsigned char* const __attribute__((address_space(4)))*)(ka.k + 256); float* outp = *(float* const __attribute__((address_space(4)))*)(ka.k + 248);
        ka.outb = (unsigned char*)outp;
        unsigned char* ws = ka.ws;
        float* rss = (float*)(ws + WS_RSS); bf16_t* xb = (bf16_t*)(ws + WS_XB); bf16_t* Hb = (bf16_t*)(ws + WS_H);
        for (int rep = 0; rep < ((ph == PROBE_PH) ? 2 : 1); ++rep) {
        int kind, arg = 0;
        switch (ph) {
            case 0: kind = 0; break;
            case 1: kind = 1; arg = 0; break;    case 2: kind = 2; arg = 0; break;
            case 3: kind = 3; arg = 0; break;    case 4: kind = 4; break;   case 5: kind = 5; break;   case 6: kind = 6; break;
            case 7: kind = 2; arg = 4; break;
            case 8: kind = 1; arg = 1; break;    case 9: kind = 2; arg = 1; break;
            case 10: kind = 1; arg = 2; break;   case 11: kind = 2; arg = 2; break;
            case 12: kind = 3; arg = 1; break;   case 13: kind = 7; break;  case 14: kind = 8; break;
            case 15: kind = 2; arg = 5; break;
            case 16: kind = 1; arg = 3; break;   default: kind = 2; arg = 3; break;
        }
        if (kind == 0) { if (PHON(0)) { MKCTX(); phase_prologue(C, ka); } }
        else if (kind == 1) { if (PHON(1)) { MKCTX();
                        pg8::Gemm g{xb, (const bf16_t*)(ws + WS_WGU) + (size_t)arg * 5632 * 1024, TOK, 5632, DM, DM};
            pg8::StaticOrder S; S.init(TOK, 5632, C.G, (int)blockIdx.x);
            pg8::EpiSwiglu E{rss, Hb};
            pg8::gemm_phase<pg8::EpiSwiglu>(C.lds, C.tid, g, S, E); }
        } else if (kind == 2) { if (PHON(2)) { MKCTX();
            pg8::Gemm g; pg8::EpiResid E;
            E.out = nullptr; E.base = nullptr; E.baseb = xb; E.xb = xb; E.alpha = 0.5f;
            if (arg < 4) { g = pg8::Gemm{Hb, (const bf16_t*)(ws + WS_WDN) + (size_t)arg * 1024 * FF, TOK, DM, FF, FF};
                if (arg == 0) { E.base = ka.in(0); E.baseb = nullptr; }
                E.rss = (arg == 0) ? rss : (arg == 1 ? rss : (arg == 2 ? rss : nullptr));
                if (arg == 3) { E.xb = nullptr; E.out = outp; }
            } else if (arg == 4) { g = pg8::Gemm{Hb + Z0_MIX, (const bf16_t*)(ws + WS_WOUT0), TOK, DM, 768, LD0}; E.alpha = 1.0f; E.rss = rss; }
            else { g = pg8::Gemm{(const bf16_t*)(ws + WS_MIX1), (const bf16_t*)(ws + WS_WOUT1), TOK, DM, DM, DM}; E.alpha = 1.0f; E.rss = rss; }
            pg8::StaticOrder S; S.init(TOK, DM, C.G, (int)blockIdx.x);
            pg8::gemm_phase<pg8::EpiResid>(C.lds, C.tid, g, S, E); }
        } else if (kind == 3) { if (PHON(3)) { MKCTX();
            pg8::Gemm g; pg8::EpiScale E; pg8::StaticOrder S;
            if (arg == 0) { g = pg8::Gemm{xb, (const bf16_t*)(ws + WS_WIN0), TOK, LD0, DM, DM}; E = pg8::EpiScale{rss, Hb, LD0}; S.init(TOK, LD0, C.G, (int)blockIdx.x); }
            else { g = pg8::Gemm{xb, (const bf16_t*)(ws + WS_WIN1), TOK, LD1, DM, DM}; E = pg8::EpiScale{rss, Hb, LD1}; S.init(TOK, LD1, C.G, (int)blockIdx.x); }
            pg8::gemm_phase<pg8::EpiScale>(C.lds, C.tid, g, S, E); }
        } else if (kind == 4) { if (PHON(4)) { MKCTX(); phase_prep0(C, ka); } }
        else if (kind == 5) { if (PHON(5)) { MKCTX(); phase_att0(C, ka); } }
        else if (kind == 6) { if (PHON(6)) { MKCTX(); phase_comb0(C, ka); } }
        else if (kind == 7) { if (PHON(7)) { MKCTX(); phase_prep1(C, ka); } }
        else { if (PHON(8)) { MKCTX(); phase_att1(C, ka); } }
        }
        if (ph + 1 < a.ph_hi) { XcdBarrier xbar; xbar.bar = (unsigned*)(ws + WS_CTL); xbar.x = xb_xcc_id(); xbar.st = (volatile LAS unsigned*)((LAS unsigned char*)lds_raw + LDS_BAR_OFF); xcd_barrier(xbar); }
    }
}

#ifndef MULTI_LAUNCH
#define MULTI_LAUNCH 0
#endif

extern "C" void kernel_launch(void* const* d_in, const int* in_sizes, int n_in, void* d_out, int out_size, void* d_ws, size_t ws_size, hipStream_t stream) {
    static int grid = 0;
    if (grid == 0) {
        if (n_in != 31 || out_size != TOK * DM || ws_size < WS_END) { fprintf(stderr, "kernel_launch: unexpected shapes n_in %d out %d ws %zu\n", n_in, out_size, ws_size); grid = -1; return; }
        int dev = 0, cus = 0, per_cu = 0;
        (void)hipGetDevice(&dev); (void)hipDeviceGetAttribute(&cus, hipDeviceAttributeMultiprocessorCount, dev);
#if MULTI_LAUNCH
        const void* fns[9] = {(const void*)mega_fwd<1>, (const void*)mega_fwd<2>, (const void*)mega_fwd<4>, (const void*)mega_fwd<8>, (const void*)mega_fwd<16>, (const void*)mega_fwd<32>, (const void*)mega_fwd<64>, (const void*)mega_fwd<128>, (const void*)mega_fwd<256>};
        for (int i = 0; i < 9; ++i) if (hipFuncSetAttribute(fns[i], hipFuncAttributeMaxDynamicSharedMemorySize, LDS_BYTES) != hipSuccess) { fprintf(stderr, "kernel_launch: hipFuncSetAttribute failed\n"); grid = -1; return; }
        per_cu = 1;
#else
        if (hipFuncSetAttribute((const void*)mega_fwd<0x1ff>, hipFuncAttributeMaxDynamicSharedMemorySize, LDS_BYTES) != hipSuccess) { fprintf(stderr, "kernel_launch: hipFuncSetAttribute failed\n"); grid = -1; return; }
        if (hipOccupancyMaxActiveBlocksPerMultiprocessor(&per_cu, (const void*)mega_fwd<0x1ff>, 512, LDS_BYTES) != hipSuccess || per_cu < 1) { fprintf(stderr, "kernel_launch: occupancy query says %d\n", per_cu); per_cu = 1; }
#endif
        (void)hipGetLastError();
        grid = cus * 1;
    }
    if (grid < 0) return;
    Args a{};
    for (int i = 0; i < 31; ++i) a.in[i] = (const float*)d_in[i];
    a.out = (float*)d_out; a.ws = (unsigned char*)d_ws;
#if MULTI_LAUNCH
    static const int kinds[NPHASE] = {0, 1, 2, 3, 4, 5, 6, 2, 1, 2, 1, 2, 3, 7, 8, 2, 1, 2};
    for (int ph = 0; ph < NPHASE; ++ph) { a.ph_lo = ph; a.ph_hi = ph + 1;
        switch (kinds[ph]) {
            case 0: hipLaunchKernelGGL(mega_fwd<1>, dim3(grid), dim3(512), LDS_BYTES, stream, a); break;
            case 1: hipLaunchKernelGGL(mega_fwd<2>, dim3(grid), dim3(512), LDS_BYTES, stream, a); break;
            case 2: hipLaunchKernelGGL(mega_fwd<4>, dim3(grid), dim3(512), LDS_BYTES, stream, a); break;
            case 3: hipLaunchKernelGGL(mega_fwd<8>, dim3(grid), dim3(512), LDS_BYTES, stream, a); break;
            case 4: hipLaunchKernelGGL(mega_fwd<16>, dim3(grid), dim3(512), LDS_BYTES, stream, a); break;
            case 5: hipLaunchKernelGGL(mega_fwd<32>, dim3(grid), dim3(512), LDS_BYTES, stream, a); break;
            case 6: hipLaunchKernelGGL(mega_fwd<64>, dim3(grid), dim3(512), LDS_BYTES, stream, a); break;
            case 7: hipLaunchKernelGGL(mega_fwd<128>, dim3(grid), dim3(512), LDS_BYTES, stream, a); break;
            default: hipLaunchKernelGGL(mega_fwd<256>, dim3(grid), dim3(512), LDS_BYTES, stream, a); break;
        }
    }
#else
    a.ph_lo = 0; a.ph_hi = NPHASE;
    (void)hipMemsetAsync((char*)d_ws + WS_CTL, 0, 16384, stream);
    void* args[] = {&a};
    hipError_t e = hipLaunchCooperativeKernel((const void*)mega_fwd<0x1ff>, dim3(grid), dim3(512), args, LDS_BYTES, stream);
    if (e != hipSuccess) fprintf(stderr, "cooperative launch failed: %s (grid %d)\n", hipGetErrorString(e), grid);
#endif
}
```
